# Optimizing an MI355X kernel written in HIP

```python
import jax
import jax.numpy as jnp
from jax import lax
import numpy as np

D_MODEL = 1024
BATCH = 2
SEQ = 16384
DEPTH = 2

POOL_WIDTH = 512
POOL_GROUPS = 4
POOL_WINDOWS = (2, 4, 8, 16)
SG_WIDTH = 512
SG_HEADS = 4
SG_CHUNK = 128
NSA_Q_HEADS = 8
NSA_KV_HEADS = 2
GROUP = NSA_Q_HEADS // NSA_KV_HEADS
HEAD_DIM = 64
Q_WIDTH = NSA_Q_HEADS * HEAD_DIM
KV_WIDTH = NSA_KV_HEADS * HEAD_DIM
ROT_DIM = HEAD_DIM // 4
ROPE_THETA = 500000.0
CMP_LEN = 32
CMP_STRIDE = 16
CMP_HIDDEN = 256
SLC_LEN = 64
SLC_TOP = 16
WINDOW = 512
Q_BLOCK = 128
NEG_INF = -1e30
FORCE_SCORE = 1e4
D_FF = 2816
N_EXPERTS = 8
TOP_K = 2
EXPERT_BLOCK = 512
PLE_DIM = 256
N_DENSE = (DEPTH + 1) // 2
N_MOE = DEPTH // 2
ALPHA = (2 * DEPTH) ** 0.25
BETA = (8 * DEPTH) ** -0.25

WIDTHS = (POOL_WIDTH, SG_WIDTH, SG_WIDTH, Q_WIDTH,
          KV_WIDTH, KV_WIDTH, KV_WIDTH, KV_WIDTH, KV_WIDTH, KV_WIDTH,
          NSA_Q_HEADS * 3, 3 * D_MODEL)
IN_WIDTH = sum(WIDTHS)
SPLIT_POINTS = tuple(int(v) for v in np.cumsum(WIDTHS)[:-1])

kernel_name = 'hybrid_pool_gmlp_nsa_moe_deepnorm'


def layer_norm(x, g, b, eps=1e-5):
    xf = x.astype(jnp.float32)
    mu = jnp.mean(xf, axis=-1, keepdims=True)
    var = jnp.mean(jnp.square(xf - mu), axis=-1, keepdims=True)
    return ((xf - mu) * lax.rsqrt(var + eps)).astype(x.dtype) * g + b


def partial_rope(x, positions):
    half = ROT_DIM // 2
    inv = ROPE_THETA ** (-jnp.arange(half, dtype=jnp.float32) / half)
    ang = positions.astype(jnp.float32)[:, :, None, None] * inv
    cos = jnp.cos(ang).astype(x.dtype)
    sin = jnp.sin(ang).astype(x.dtype)
    x1 = x[..., :half]
    x2 = x[..., half:ROT_DIM]
    return jnp.concatenate([x1 * cos - x2 * sin, x2 * cos + x1 * sin, x[..., ROT_DIM:]], axis=-1)


def swiglu(x, wg, wu, wd):
    return (jax.nn.silu(x @ wg) * (x @ wu)) @ wd


def pool_mixer(a, pool_w, pool_scale):
    B_, S_, _ = a.shape
    af = a.astype(jnp.float32)
    wmax = max(POOL_WINDOWS)
    cs = jnp.concatenate([jnp.zeros((B_, wmax, POOL_WIDTH), jnp.float32), jnp.cumsum(af, axis=1)], axis=1)
    gw = POOL_WIDTH // POOL_GROUPS
    outs = []
    for g, w in enumerate(POOL_WINDOWS):
        c = cs[:, :, g * gw:(g + 1) * gw]
        win_sum = c[:, wmax:] - c[:, wmax - w:wmax - w + S_]
        count = jnp.minimum(jnp.arange(1, S_ + 1), w).astype(jnp.float32)[None, :, None]
        outs.append(win_sum / count)
    d = (jnp.concatenate(outs, axis=-1) - af).astype(a.dtype).reshape(B_, S_, POOL_GROUPS, gw)
    y = jnp.einsum('bsgc,gcd->bsgd', d, pool_w).reshape(B_, S_, POOL_WIDTH)
    return y * pool_scale


def spatial_gating_mixer(u, v, ln_g, ln_b, sg_w, sg_b):
    B_, S_, _ = u.shape
    u = jax.nn.gelu(u)
    v = layer_norm(jax.nn.gelu(v), ln_g, ln_b)
    nc = S_ // SG_CHUNK
    hc = SG_WIDTH // SG_HEADS
    v = v.reshape(B_, nc, SG_CHUNK, SG_HEADS, hc)
    causal = jnp.tril(jnp.ones((SG_CHUNK, SG_CHUNK), dtype=bool))
    ws = jnp.where(causal[None], sg_w, 0.0)
    mixed = jnp.einsum('gts,bnsgc->bntgc', ws, v) + sg_b.T[None, None, :, :, None]
    return u * mixed.reshape(B_, S_, SG_WIDTH)


def compress(kv, pos_enc, w1, w2):
    B_, H_, S_, d = kv.shape
    ratio = CMP_LEN // CMP_STRIDE
    chunks = kv.reshape(B_, H_, S_ // CMP_STRIDE, CMP_STRIDE, d)
    n_cmp = S_ // CMP_STRIDE - ratio + 1
    blocks = jnp.concatenate([chunks[:, :, r:r + n_cmp] for r in range(ratio)], axis=3)
    blocks = (blocks + pos_enc).reshape(B_, H_, n_cmp, CMP_LEN * d)
    return jax.nn.gelu(blocks @ w1) @ w2


def nsa_attention(q, k_cmp, v_cmp, k_slc, v_slc, k_win, v_win, gates):
    B_, H_, G_, S_, d = q.shape
    n_cmp = k_cmp.shape[2]
    n_slc = S_ // SLC_LEN
    n_top = min(SLC_TOP, n_slc)
    ratio = CMP_LEN // CMP_STRIDE
    n_chunks = S_ // CMP_STRIDE
    k_blk = k_slc.reshape(B_, H_, n_slc, SLC_LEN, d)
    v_blk = v_slc.reshape(B_, H_, n_slc, SLC_LEN, d)
    pad_w = ((0, 0), (0, 0), (WINDOW, 0), (0, 0))
    k_pad = jnp.pad(k_win, pad_w)
    v_pad = jnp.pad(v_win, pad_w)
    cmp_end = jnp.arange(n_cmp) * CMP_STRIDE + CMP_LEN - 1
    blk_id = jnp.arange(n_slc)
    gather = jax.vmap(jax.vmap(lambda tbl, ix: tbl[ix]))

    def block(n):
        qs = n * Q_BLOCK
        t = qs + jnp.arange(Q_BLOCK)
        qb = lax.dynamic_slice_in_dim(q, qs, Q_BLOCK, axis=3)
        gb = lax.dynamic_slice_in_dim(gates, qs, Q_BLOCK, axis=3)
        s = jnp.einsum('bhgqd,bhkd->bhgqk', qb, k_cmp).astype(jnp.float32)
        valid = cmp_end[None, :] <= t[:, None]
        p_cmp = jax.nn.softmax(jnp.where(valid, s, NEG_INF), axis=-1) * valid
        o_cmp = jnp.einsum('bhgqk,bhkd->bhgqd', p_cmp.astype(q.dtype), v_cmp)
        imp = jnp.pad(p_cmp.sum(axis=2), ((0, 0), (0, 0), (0, 0), (ratio - 1, ratio - 1)))
        imp = sum(imp[..., r:r + n_chunks] for r in range(ratio))
        imp = imp.reshape(B_, H_, Q_BLOCK, n_slc, SLC_LEN // CMP_STRIDE).sum(-1)
        cur = t[:, None] // SLC_LEN
        forced = (blk_id == 0) | (blk_id == cur) | (blk_id == cur - 1)
        score = jnp.where(forced, FORCE_SCORE, imp)
        score = jnp.where(blk_id <= cur, score, -1.0)
        _, idx = lax.top_k(score, n_top)
        k_sel = gather(k_blk, idx)
        v_sel = gather(v_blk, idx)
        s = jnp.einsum('bhgqd,bhqnld->bhgqnl', qb, k_sel).astype(jnp.float32)
        pos = idx[..., None] * SLC_LEN + jnp.arange(SLC_LEN)
        ok = (pos <= t[:, None, None])[:, :, None]
        s = jnp.where(ok, s, NEG_INF).reshape(B_, H_, G_, Q_BLOCK, n_top * SLC_LEN)
        p = jax.nn.softmax(s, axis=-1).reshape(B_, H_, G_, Q_BLOCK, n_top, SLC_LEN)
        o_slc = jnp.einsum('bhgqnl,bhqnld->bhgqd', p.astype(q.dtype), v_sel)
        kw = lax.dynamic_slice_in_dim(k_pad, qs, WINDOW + Q_BLOCK, axis=2)
        vw = lax.dynamic_slice_in_dim(v_pad, qs, WINDOW + Q_BLOCK, axis=2)
        s_pos = qs - WINDOW + jnp.arange(WINDOW + Q_BLOCK)
        diff = t[:, None] - s_pos[None, :]
        ok_w = (diff >= 0) & (diff < WINDOW) & (s_pos[None, :] >= 0)
        s = jnp.einsum('bhgqd,bhkd->bhgqk', qb, kw).astype(jnp.float32)
        p = jax.nn.softmax(jnp.where(ok_w, s, NEG_INF), axis=-1)
        o_win = jnp.einsum('bhgqk,bhkd->bhgqd', p.astype(q.dtype), vw)
        return gb[..., 0:1] * o_cmp + gb[..., 1:2] * o_slc + gb[..., 2:3] * o_win

    out = lax.map(block, jnp.arange(S_ // Q_BLOCK))
    return jnp.moveaxis(out, 0, 3).reshape(B_, H_, G_, S_, d)


def token_mixer(x, positions, w_in, pool_w, pool_scale, sg_ln_g, sg_ln_b, sg_w, sg_b,
                cmp_k_pos, cmp_k_w1, cmp_k_w2, cmp_v_pos, cmp_v_w1, cmp_v_w2,
                w_pool_out, w_sg_out, w_nsa_out, w_out):
    B_, S_, _ = x.shape
    proj = x @ w_in
    a, u, v, q, kc, vc, ks, vs, kw, vw, nsa_g, br_g = jnp.split(proj, SPLIT_POINTS, axis=-1)
    y_pool = pool_mixer(a, pool_w, pool_scale) @ w_pool_out
    y_sg = spatial_gating_mixer(u, v, sg_ln_g, sg_ln_b, sg_w, sg_b) @ w_sg_out

    q = partial_rope(q.reshape(B_, S_, NSA_Q_HEADS, HEAD_DIM), positions) * HEAD_DIM ** -0.5
    q = q.reshape(B_, S_, NSA_KV_HEADS, GROUP, HEAD_DIM).transpose(0, 2, 3, 1, 4)

    def kv_heads(t, rope):
        t = t.reshape(B_, S_, NSA_KV_HEADS, HEAD_DIM)
        if rope:
            t = partial_rope(t, positions)
        return t.transpose(0, 2, 1, 3)

    k_cmp = compress(kv_heads(kc, True), cmp_k_pos, cmp_k_w1, cmp_k_w2)
    v_cmp = compress(kv_heads(vc, False), cmp_v_pos, cmp_v_w1, cmp_v_w2)
    gates = jax.nn.sigmoid(nsa_g.reshape(B_, S_, NSA_KV_HEADS, GROUP, 3).transpose(0, 2, 3, 1, 4))
    o = nsa_attention(q, k_cmp, v_cmp, kv_heads(ks, True), kv_heads(vs, False),
                      kv_heads(kw, True), kv_heads(vw, False), gates)
    y_nsa = o.transpose(0, 3, 1, 2, 4).reshape(B_, S_, Q_WIDTH) @ w_nsa_out

    g_pool, g_sg, g_nsa = jnp.split(jax.nn.sigmoid(br_g), 3, axis=-1)
    return (g_pool * y_pool + g_sg * y_sg + g_nsa * y_nsa) @ w_out


def moe_swiglu(x, w_router, b_router, w_gate, w_up, w_down):
    B_, S_, D_ = x.shape
    T = B_ * S_
    TK = T * TOP_K
    xt = x.reshape(T, D_)
    logits = (xt @ w_router).astype(jnp.float32) + b_router.astype(jnp.float32)
    top_logit, top_e = lax.top_k(logits, TOP_K)
    weights = jax.nn.softmax(top_logit, axis=-1)
    flat_e = top_e.reshape(-1)
    flat_tok = jnp.arange(TK, dtype=jnp.int32) // TOP_K
    order = jnp.argsort(flat_e)
    e_sorted = flat_e[order]
    counts = jnp.bincount(flat_e, length=N_EXPERTS)
    padded = (counts + EXPERT_BLOCK - 1) // EXPERT_BLOCK * EXPERT_BLOCK
    start = jnp.cumsum(counts) - counts
    pstart = jnp.cumsum(padded) - padded
    dest = pstart[e_sorted] + jnp.arange(TK) - start[e_sorted]
    n_rows = (-(-TK // EXPERT_BLOCK) + N_EXPERTS) * EXPERT_BLOCK
    n_blocks = n_rows // EXPERT_BLOCK
    row_tok = jnp.full((n_rows,), T, jnp.int32).at[dest].set(flat_tok[order])
    row_w = jnp.zeros((n_rows,), jnp.float32).at[dest].set(weights.reshape(-1)[order])
    block_e = jnp.searchsorted(jnp.cumsum(padded), jnp.arange(n_blocks) * EXPERT_BLOCK, side='right')
    block_e = jnp.minimum(block_e, N_EXPERTS - 1)
    x_rows = jnp.concatenate([xt, jnp.zeros((1, D_), x.dtype)], axis=0)[row_tok]
    x_rows = x_rows.reshape(n_blocks, EXPERT_BLOCK, D_)

    def expert_block(args):
        xb, e = args
        return swiglu(xb, w_gate[e], w_up[e], w_down[e])

    y = lax.map(expert_block, (x_rows, block_e)).reshape(n_rows, D_)
    y = y * row_w[:, None].astype(y.dtype)
    out = jnp.zeros((T + 1, D_), y.dtype).at[row_tok].add(y)[:T]
    return out.reshape(B_, S_, D_)


def setup_inputs(seed: int = 0) -> dict:
    key = jax.random.key(seed)
    keys = iter(jax.random.split(key, 40))

    def nrm(shape, scale):
        return jax.random.normal(next(keys), shape, jnp.float32) * scale

    gw = POOL_WIDTH // POOL_GROUPS
    hc = SG_WIDTH // SG_HEADS
    return {
        'x': nrm((BATCH, SEQ, D_MODEL), 1.0),
        'p': nrm((DEPTH, BATCH, SEQ, PLE_DIM), 1.0),
        'positions': jax.random.randint(next(keys), (BATCH, 1), 0, 4096, jnp.int32) + jnp.arange(SEQ, dtype=jnp.int32)[None, :],
        'w_in': nrm((DEPTH, D_MODEL, IN_WIDTH), D_MODEL ** -0.5),
        'pool_w': nrm((DEPTH, POOL_GROUPS, gw, gw), gw ** -0.5),
        'pool_scale': 1.0 + nrm((DEPTH, POOL_WIDTH), 0.1),
        'sg_ln_g': 1.0 + nrm((DEPTH, SG_WIDTH), 0.05),
        'sg_ln_b': nrm((DEPTH, SG_WIDTH), 0.02),
        'sg_w': nrm((DEPTH, SG_HEADS, SG_CHUNK, SG_CHUNK), 0.5 * SG_CHUNK ** -0.5),
        'sg_b': 1.0 + nrm((DEPTH, SG_HEADS, SG_CHUNK), 0.1),
        'cmp_k_pos': nrm((DEPTH, CMP_LEN, HEAD_DIM), 0.02),
        'cmp_k_w1': nrm((DEPTH, CMP_LEN * HEAD_DIM, CMP_HIDDEN), (CMP_LEN * HEAD_DIM) ** -0.5),
        'cmp_k_w2': nrm((DEPTH, CMP_HIDDEN, HEAD_DIM), CMP_HIDDEN ** -0.5),
        'cmp_v_pos': nrm((DEPTH, CMP_LEN, HEAD_DIM), 0.02),
        'cmp_v_w1': nrm((DEPTH, CMP_LEN * HEAD_DIM, CMP_HIDDEN), (CMP_LEN * HEAD_DIM) ** -0.5),
        'cmp_v_w2': nrm((DEPTH, CMP_HIDDEN, HEAD_DIM), CMP_HIDDEN ** -0.5),
        'w_pool_out': nrm((DEPTH, POOL_WIDTH, D_MODEL), POOL_WIDTH ** -0.5),
        'w_sg_out': nrm((DEPTH, SG_WIDTH, D_MODEL), SG_WIDTH ** -0.5),
        'w_nsa_out': nrm((DEPTH, Q_WIDTH, D_MODEL), Q_WIDTH ** -0.5),
        'w_out': nrm((DEPTH, D_MODEL, D_MODEL), BETA * D_MODEL ** -0.5),
        'ln1_g': 1.0 + nrm((DEPTH, D_MODEL), 0.05),
        'ln1_b': nrm((DEPTH, D_MODEL), 0.02),
        'ffn_w_gate': nrm((N_DENSE, D_MODEL, D_FF), D_MODEL ** -0.5),
        'ffn_w_up': nrm((N_DENSE, D_MODEL, D_FF), D_MODEL ** -0.5),
        'ffn_w_down': nrm((N_DENSE, D_FF, D_MODEL), BETA * D_FF ** -0.5),
        'moe_router': nrm((N_MOE, D_MODEL, N_EXPERTS), D_MODEL ** -0.5),
        'moe_router_b': nrm((N_MOE, N_EXPERTS), 0.01),
        'moe_w_gate': nrm((N_MOE, N_EXPERTS, D_MODEL, D_FF), D_MODEL ** -0.5),
        'moe_w_up': nrm((N_MOE, N_EXPERTS, D_MODEL, D_FF), D_MODEL ** -0.5),
        'moe_w_down': nrm((N_MOE, N_EXPERTS, D_FF, D_MODEL), BETA * D_FF ** -0.5),
        'ple_gate_w': nrm((DEPTH, D_MODEL, D_MODEL), D_MODEL ** -0.5),
        'ple_gate_b': nrm((DEPTH, D_MODEL), 0.02),
        'ple_proj': nrm((DEPTH, PLE_DIM, D_MODEL), BETA * PLE_DIM ** -0.5),
        'ln2_g': 1.0 + nrm((DEPTH, D_MODEL), 0.05),
        'ln2_b': nrm((DEPTH, D_MODEL), 0.02),
    }


def reference(x, p, positions, w_in, pool_w, pool_scale, sg_ln_g, sg_ln_b, sg_w, sg_b,
              cmp_k_pos, cmp_k_w1, cmp_k_w2, cmp_v_pos, cmp_v_w1, cmp_v_w2,
              w_pool_out, w_sg_out, w_nsa_out, w_out, ln1_g, ln1_b,
              ffn_w_gate, ffn_w_up, ffn_w_down,
              moe_router, moe_router_b, moe_w_gate, moe_w_up, moe_w_down,
              ple_gate_w, ple_gate_b, ple_proj, ln2_g, ln2_b):
    for i in range(DEPTH):
        h = token_mixer(x, positions, w_in[i], pool_w[i], pool_scale[i], sg_ln_g[i], sg_ln_b[i],
                        sg_w[i], sg_b[i], cmp_k_pos[i], cmp_k_w1[i], cmp_k_w2[i],
                        cmp_v_pos[i], cmp_v_w1[i], cmp_v_w2[i],
                        w_pool_out[i], w_sg_out[i], w_nsa_out[i], w_out[i])
        x = layer_norm(ALPHA * x + h, ln1_g[i], ln1_b[i])
        j = i // 2
        if i % 2 == 0:
            f = swiglu(x, ffn_w_gate[j], ffn_w_up[j], ffn_w_down[j])
        else:
            f = moe_swiglu(x, moe_router[j], moe_router_b[j], moe_w_gate[j], moe_w_up[j], moe_w_down[j])
        ple = jax.nn.sigmoid(x @ ple_gate_w[i] + ple_gate_b[i]) * (p[i] @ ple_proj[i])
        x = layer_norm(ALPHA * x + f + ple, ln2_g[i], ln2_b[i])
    return x
```

```cpp
#include <hip/hip_runtime.h>
#include <stdint.h>
#include <stdio.h>
#include <string.h>

#define DI __device__ __forceinline__
typedef unsigned short u16;
using bf16x8 = __attribute__((ext_vector_type(8))) short;
using f32x4  = __attribute__((ext_vector_type(4))) float;
using f32x16 = __attribute__((ext_vector_type(16))) float;
using u32x4  = __attribute__((ext_vector_type(4))) unsigned;
using u32x2  = __attribute__((ext_vector_type(2))) unsigned;
typedef __bf16 bf2_t __attribute__((ext_vector_type(2)));
typedef float  f2_t  __attribute__((ext_vector_type(2)));

constexpr int T_ = 32768, S_ = 16384, D_ = 1024, NB_ = 2;
constexpr int INW = 5912, DFF = 2816, NEXP = 8;
constexpr float ALPHA_ = 1.41421356237309515f;
constexpr int NTHR = 512;
constexpr int LDS_BYTES = 148480;

DI int tid_opaque() { int t = threadIdx.x; asm volatile("" : "+v"(t)); return t; }
DI unsigned pk2(float a, float b) { f2_t v = {a, b}; bf2_t r = __builtin_convertvector(v, bf2_t); return __builtin_bit_cast(unsigned, r); }
DI u16 f2bf(float a) { return (u16)(pk2(a, 0.f) & 0xffffu); }
DI float bf2f(u16 h) { return __uint_as_float(((unsigned)h) << 16); }
DI float bflo(unsigned u) { return __uint_as_float(u << 16); }
DI float bfhi(unsigned u) { return __uint_as_float(u & 0xffff0000u); }
DI float fsigmoid(float x) { return __builtin_amdgcn_rcpf(1.f + __expf(-x)); }
DI float fgelu(float x) { float y = 0.7978845608028654f * (x + 0.044715f * x * x * x); return x * fsigmoid(2.f * y); }
DI float fsilu(float x) { return x * fsigmoid(x); }

typedef unsigned u2v_t __attribute__((ext_vector_type(2)));
template <int CTRL> DI unsigned dpp_mov(unsigned x) { return (unsigned)__builtin_amdgcn_update_dpp(0, (int)x, CTRL, 0xF, 0xF, true); }
DI float fmax_x16(float x) { const unsigned u = __float_as_uint(x); const u2v_t r = __builtin_amdgcn_permlane16_swap(u, u, false, false); return fmaxf(__uint_as_float(r[0]), __uint_as_float(r[1])); }
DI float fmax_x32(float x) { const unsigned u = __float_as_uint(x); const u2v_t r = __builtin_amdgcn_permlane32_swap(u, u, false, false); return fmaxf(__uint_as_float(r[0]), __uint_as_float(r[1])); }
DI float fsum_x16(float x) { const unsigned u = __float_as_uint(x); const u2v_t r = __builtin_amdgcn_permlane16_swap(u, u, false, false); return __uint_as_float(r[0]) + __uint_as_float(r[1]); }
DI float fsum_x32(float x) { const unsigned u = __float_as_uint(x); const u2v_t r = __builtin_amdgcn_permlane32_swap(u, u, false, false); return __uint_as_float(r[0]) + __uint_as_float(r[1]); }
DI unsigned long long umax64(unsigned long long a, unsigned long long b) { return a > b ? a : b; }
DI unsigned long long wave_max_u64(unsigned long long v) {
  unsigned lo = (unsigned)v, hi = (unsigned)(v >> 32);
#define WM_STEP(CTRL) { const unsigned lo2 = dpp_mov<CTRL>(lo), hi2 = dpp_mov<CTRL>(hi); const unsigned long long o = ((unsigned long long)hi2 << 32) | lo2, c = ((unsigned long long)hi << 32) | lo; \
    const unsigned long long m_ = umax64(o, c); lo = (unsigned)m_; hi = (unsigned)(m_ >> 32); }
  WM_STEP(0xB1) WM_STEP(0x4E) WM_STEP(0x141) WM_STEP(0x140)
#undef WM_STEP
  { const u2v_t rl = __builtin_amdgcn_permlane16_swap(lo, lo, false, false), rh = __builtin_amdgcn_permlane16_swap(hi, hi, false, false);
    const unsigned long long m_ = umax64(((unsigned long long)rh[0] << 32) | rl[0], ((unsigned long long)rh[1] << 32) | rl[1]); lo = (unsigned)m_; hi = (unsigned)(m_ >> 32); }
  { const u2v_t rl = __builtin_amdgcn_permlane32_swap(lo, lo, false, false), rh = __builtin_amdgcn_permlane32_swap(hi, hi, false, false);
    const unsigned long long m_ = umax64(((unsigned long long)rh[0] << 32) | rl[0], ((unsigned long long)rh[1] << 32) | rl[1]); lo = (unsigned)m_; hi = (unsigned)(m_ >> 32); }
  return ((unsigned long long)hi << 32) | lo;
}
DI float wave_sum(float v) {
  v += __uint_as_float(dpp_mov<0xB1>(__float_as_uint(v)));
  v += __uint_as_float(dpp_mov<0x4E>(__float_as_uint(v)));
  v += __uint_as_float(dpp_mov<0x141>(__float_as_uint(v)));
  v += __uint_as_float(dpp_mov<0x140>(__float_as_uint(v)));
  return fsum_x32(fsum_x16(v));
}
struct P {
  const float *x, *p; const int* pos;
  const float *w_in, *pool_w, *pool_scale, *sg_ln_g, *sg_ln_b, *sg_w, *sg_b;
  const float *ck_pos, *ck_w1, *ck_w2, *cv_pos, *cv_w1, *cv_w2;
  const float *w_pool_out, *w_sg_out, *w_nsa_out, *w_out, *ln1_g, *ln1_b;
  const float *ffn_g, *ffn_u, *ffn_d, *moe_r, *moe_rb, *moe_g, *moe_u, *moe_d;
  const float *ple_gw, *ple_gb, *ple_pj, *ln2_g, *ln2_b;
  float* out; char* ws;
};

constexpr size_t MB = 1048576;
constexpr size_t OFF_BAR   = 0;
constexpr size_t OFF_CNT   = 16384;
constexpr size_t ZERO_BYTES = 32768;
constexpr size_t OFF_ROPE  = 65536;
constexpr size_t OFF_NG    = OFF_ROPE + 2 * MB;
constexpr size_t OFF_KCMP  = OFF_NG + 3 * MB;
constexpr size_t OFF_VCMPT = OFF_KCMP + MB / 2;
constexpr size_t OFF_POSB  = OFF_VCMPT + MB / 2;
constexpr size_t OFF_AH    = OFF_POSB + 65536;
constexpr size_t OFF_TOKE  = OFF_AH + 4 * MB;
constexpr size_t OFF_TOKW  = OFF_TOKE + MB / 4;
constexpr size_t OFF_ROWT  = OFF_TOKW + MB / 4;
constexpr size_t OFF_ROWW  = OFF_ROWT + 2 * MB;
constexpr size_t OFF_W     = 16 * MB;
constexpr size_t WL_WINT = 0;
constexpr size_t WL_WGT  = WL_WINT + (size_t)3072 * 1024 * 2;
constexpr size_t WL_WEFF = WL_WGT  + (size_t)3072 * 1024 * 2;
constexpr size_t WL_WSG  = WL_WEFF + (size_t)1024 * 512 * 2;
constexpr size_t WL_WNSA = WL_WSG  + (size_t)1024 * 512 * 2;
constexpr size_t WL_WOUT = WL_WNSA + (size_t)1024 * 512 * 2;
constexpr size_t WL_WPG  = WL_WOUT + (size_t)1024 * 1024 * 2;
constexpr size_t WL_WPP  = WL_WPG  + (size_t)1024 * 1024 * 2;
constexpr size_t WL_W1K  = WL_WPP  + (size_t)1024 * 256 * 2;
constexpr size_t WL_W1V  = WL_W1K  + (size_t)256 * 2048 * 2;
constexpr size_t WL_SGW  = WL_W1V  + (size_t)256 * 2048 * 2;
constexpr size_t WL_SIZE = WL_SGW  + (size_t)4 * 128 * 128 * 2;
constexpr size_t OFF_WFFN = OFF_W + 2 * WL_SIZE;
constexpr size_t FFN_E_SIZE = (size_t)5632 * 1024 * 2 + (size_t)1024 * 2816 * 2;
constexpr size_t OFF_WMOE = OFF_WFFN + FFN_E_SIZE;
constexpr size_t OFF_XB   = OFF_WMOE + 8 * FFN_E_SIZE;
constexpr size_t OFF_RB   = OFF_XB + (size_t)T_ * 1024 * 2;
constexpr size_t TB512 = (size_t)T_ * 512 * 2;
constexpr size_t KVB   = (size_t)4 * S_ * 64 * 2;
constexpr size_t RB_A   = OFF_RB;
constexpr size_t RB_GU  = RB_A + TB512;
constexpr size_t RB_GV  = RB_GU + TB512;
constexpr size_t RB_Q   = RB_GV + TB512;
constexpr size_t RB_KC  = RB_Q + TB512;
constexpr size_t RB_VC  = RB_KC + KVB;
constexpr size_t RB_KS  = RB_VC + KVB;
constexpr size_t RB_VST = RB_KS + KVB;
constexpr size_t RB_KW  = RB_VST + KVB;
constexpr size_t RB_VWT = RB_KW + KVB;
constexpr size_t RB_HID = RB_VWT + KVB + MB;
constexpr size_t RB_DB   = RB_HID + 16 * MB;
constexpr size_t RB_YB   = RB_DB + TB512;
constexpr size_t RB_O    = RB_YB + TB512;
constexpr size_t RB_GF   = OFF_RB;
constexpr size_t RB_MRG  = RB_Q;
constexpr size_t RB_SCR4 = RB_YB + TB512;
constexpr size_t RB_SCM4 = OFF_RB;
constexpr size_t RB_G    = OFF_RB + 96 * MB;
constexpr size_t RB_PB   = OFF_RB;
constexpr size_t RB_SCRP = OFF_RB + 16 * MB;
constexpr size_t RB_ACT  = OFF_RB;
constexpr size_t RB_SIZE = 290 * MB;
constexpr size_t WS_NEED = OFF_RB + RB_SIZE;

#define XB_TMO      128
#define XB_XCNT(j)  (256  + 64 * (j))
#define XB_XSUB(j)  (1280 + 64 * (j))
#define XB_XGEN(j)  (2304 + 64 * (j))
#define XB_TOP      3328
#define XB_TOPGEN   3392
#define XCD_BAR_WORDS 3456
#define XB_SPIN_CAP (1u << 22)
#define LAS __attribute__((address_space(3)))

DI unsigned xb_ld(unsigned* p)              { return __hip_atomic_load(p, __ATOMIC_RELAXED, __HIP_MEMORY_SCOPE_AGENT); }
DI unsigned xb_add(unsigned* p, unsigned v) { return __hip_atomic_fetch_add(p, v, __ATOMIC_RELAXED, __HIP_MEMORY_SCOPE_AGENT); }
DI unsigned xb_xcc_id() { return (unsigned)__builtin_amdgcn_s_getreg((3 << 11) | 20) & 0xFu; }
#define XB_SPIN(cond, bar) do { unsigned _sp = 0; while (cond) { __builtin_amdgcn_s_sleep(1); \
    if ((++_sp & 255u) == 0u) { if (xb_ld(&(bar)[XB_TMO])) break; if (_sp > XB_SPIN_CAP) { atomicAdd(&(bar)[XB_TMO], 1u); break; } } } } while (0)

struct XcdBarrier { unsigned* bar; unsigned x; volatile LAS unsigned* st; };

DI XcdBarrier xcd_barrier_post(unsigned* bar, volatile LAS unsigned* st) {
    XcdBarrier b; b.bar = bar; b.x = xb_xcc_id(); b.st = st;
    if (threadIdx.x == 0) (void)xb_add(&bar[XB_XCNT(b.x)], 1u);
    return b;
}
DI void xcd_barrier_complete(unsigned* bar, unsigned x, unsigned& nloc, unsigned& nx) {
    const unsigned G = gridDim.x * gridDim.y * gridDim.z;
    unsigned sum, cnt, mine, sp = 0u;
    for (;;) {
        sum = 0u; cnt = 0u; mine = 0u;
#pragma unroll
        for (unsigned j = 0; j < 16; ++j) { const unsigned c = xb_ld(&bar[XB_XCNT(j)]); sum += c; cnt += (c > 0u) ? 1u : 0u; mine = (j == x) ? c : mine; }
        if (sum == G) break;
        __builtin_amdgcn_s_sleep(1);
        if ((++sp & 255u) == 0u) { if (xb_ld(&bar[XB_TMO])) break; if (sp > XB_SPIN_CAP) { atomicAdd(&bar[XB_TMO], 1u); break; } }
    }
    nloc = mine > 0u ? mine : 1u; nx = cnt > 0u ? cnt : 1u;
}
DI void xcd_barrier(const XcdBarrier& b) {
    asm volatile("s_waitcnt vmcnt(0)" ::: "memory");
    __syncthreads();
    if (threadIdx.x == 0) {
        unsigned* bar = b.bar;
        __builtin_amdgcn_s_waitcnt(0);
        unsigned nloc = b.st[0], nx = b.st[1];
        if (nloc == 0u) { xcd_barrier_complete(bar, b.x, nloc, nx); b.st[0] = nloc; b.st[1] = nx; }
        const unsigned old = xb_add(&bar[XB_XSUB(b.x)], 1u);
        const unsigned gen = old / nloc;
        if (old + 1u == (gen + 1u) * nloc) {
            __builtin_amdgcn_fence(__ATOMIC_RELEASE, "agent");
            asm volatile("s_waitcnt vmcnt(0)" ::: "memory");
            const unsigned og = xb_add(&bar[XB_TOP], 1u);
            const unsigned tg = og / nx;
            if (og + 1u == (tg + 1u) * nx) xb_add(&bar[XB_TOPGEN], 1u);
            else XB_SPIN(xb_ld(&bar[XB_TOPGEN]) == tg, bar);
            __builtin_amdgcn_fence(__ATOMIC_ACQUIRE, "agent");
            xb_add(&bar[XB_XGEN(b.x)], 1u);
            asm volatile("s_waitcnt vmcnt(0)" ::: "memory");
        } else {
            XB_SPIN(xb_ld(&bar[XB_XGEN(b.x)]) == gen, bar);
            __builtin_amdgcn_fence(__ATOMIC_ACQUIRE, "agent");
            asm volatile("s_waitcnt vmcnt(0)" ::: "memory");
        }
    }
    __syncthreads();
}

constexpr int BK = 64, HALF = 128, HT = HALF * BK;
DI int lds_byte(int r, int c) { int st = (r >> 4) * 2 + (c >> 5), rr = r & 15, cc = c & 31, ob = rr * 64 + cc * 2; return st * 1024 + (ob ^ (((ob >> 9) & 1) << 5)); }
DI void stage_rc(int b, int& R, int& C) { int st = b / 1024, sb = b % 1024, swz = sb ^ (((sb >> 9) & 1) << 5); R = (st >> 1) * 16 + swz / 64; C = (st & 1) * 32 + (swz % 64) / 2; }

DI int blk_off(int row, int ld, int kt) { return (((row >> 8) * (ld >> 6) + kt) * 256 + (row & 255)) * 64; }
template <bool ABLK = false, bool BBLK = false, bool AGATHER = false>
DI void gemm256(const u16* __restrict__ A, long lda, int ar0, int ar1, int ar2, int ar3,
                const u16* __restrict__ Bt, long ldb, int bcol, int nt, u16* shm, f32x4 (&acc)[2][2][4][2], int kt0 = 0) {
  #define SA(b,h) (shm + ((b) * 2 + (h)) * HT)
  #define SB(b,h) (shm + (4 + (b) * 2 + (h)) * HT)
  #define GLDS(g, l) __builtin_amdgcn_global_load_lds((const unsigned*)(g), (__attribute__((address_space(3))) unsigned*)(l), 16, 0, 0)
  #define STAGE_A(TT, Pp, hh, kt) do { const char* _b = (const char*)A + (size_t)((kt) + kt0) * stepA; \
      GLDS(_b + OFFA((hh) * 2), (char*)(Pp) + (TT) * 16); \
      GLDS(_b + OFFA((hh) * 2 + 1), (char*)(Pp) + (TT) * 16 + 8192); } while (0)
  #define STAGE_B(TT, Pp, hh, kt) do { const char* _b = (const char*)Bt + (size_t)((kt) + kt0) * stepB; \
      GLDS(_b + (offB0 + (unsigned)((hh) * 2) * rowsB), (char*)(Pp) + (TT) * 16); \
      GLDS(_b + (offB0 + (unsigned)((hh) * 2 + 1) * rowsB), (char*)(Pp) + (TT) * 16 + 8192); } while (0)
  #define LDA(dst,b,h) for (int m = 0; m < 4; ++m) for (int k = 0; k < 2; ++k) \
      dst[m][k] = *reinterpret_cast<const bf16x8*>((char*)SA(b,h) + lds_byte(wr * 64 + m * 16 + fr, k * 32 + fq * 8))
  #define LDB(dst,b,h) for (int n = 0; n < 2; ++n) for (int k = 0; k < 2; ++k) \
      dst[n][k] = *reinterpret_cast<const bf16x8*>((char*)SB(b,h) + lds_byte(wc * 32 + n * 16 + fr, k * 32 + fq * 8))
  #define MMA(ai,bj,At,Bf) do { __builtin_amdgcn_s_setprio(1); \
      for (int m = 0; m < 4; ++m) for (int n = 0; n < 2; ++n) for (int k = 0; k < 2; ++k) \
        acc[ai][bj][m][n] = __builtin_amdgcn_mfma_f32_16x16x32_bf16(At[m][k], Bf[n][k], acc[ai][bj][m][n], 0, 0, 0); \
      __builtin_amdgcn_s_setprio(0); } while (0)
  #define WAIT_V(n) asm volatile("s_waitcnt vmcnt(" #n ")" ::: "memory")
  #define WAIT_L(n) asm volatile("s_waitcnt lgkmcnt(" #n ")" ::: "memory")
  #define BAR __builtin_amdgcn_s_barrier()
  #define SCHED __builtin_amdgcn_sched_barrier(0)
  int tx = threadIdx.x; asm volatile("" : "+v"(tx));
  int wid = tx >> 6, lane = tx & 63, wr = wid >> 2, wc = wid & 3, fr = lane & 15, fq = lane >> 4;
  unsigned offA0, offA1 = 0, offA2 = 0, offA3 = 0, offB0;
  const unsigned stepA = ABLK ? 32768u : 128u, stepB = BBLK ? 32768u : 128u;
  const unsigned rowsA = ABLK ? 8192u : (unsigned)lda * 128u, rowsB = BBLK ? 8192u : (unsigned)ldb * 128u;
  {
    int _r, _c; stage_rc(tx * 16, _r, _c);
    #define ROW_OFF(BLK, row, ld) ((unsigned)((BLK) ? blk_off((row), (int)(ld), 0) : (row) * (int)(ld)) * 2u + (unsigned)_c * 2u)
    offA0 = ROW_OFF(ABLK, ar0, lda);
    if (AGATHER) { offA1 = ROW_OFF(ABLK, ar1, lda); offA2 = ROW_OFF(ABLK, ar2, lda); offA3 = ROW_OFF(ABLK, ar3, lda); }
    offB0 = ROW_OFF(BBLK, bcol + _r, ldb);
    #undef ROW_OFF
  }
  #define OFFA(k) (AGATHER ? ((k) == 0 ? offA0 : (k) == 1 ? offA1 : (k) == 2 ? offA2 : offA3) : offA0 + (unsigned)(k) * rowsA)
#pragma unroll
  for (int a = 0; a < 2; ++a)
#pragma unroll
    for (int b = 0; b < 2; ++b)
#pragma unroll
      for (int m = 0; m < 4; ++m)
#pragma unroll
        for (int n = 0; n < 2; ++n) acc[a][b][m][n] = f32x4{0.f, 0.f, 0.f, 0.f};
  bf16x8 At[4][2], B0[2][2], B1[2][2];
  STAGE_B(tx, SB(0,0), 0, 0); STAGE_A(tx, SA(0,0), 0, 0);
  STAGE_B(tx, SB(0,1), 1, 0); STAGE_A(tx, SA(0,1), 1, 0);
  if (wr == 1) BAR;
  WAIT_V(4); BAR;
  STAGE_B(tx, SB(1,0), 0, 1); STAGE_A(tx, SA(1,0), 0, 1); STAGE_B(tx, SB(1,1), 1, 1);
  WAIT_V(6); BAR;
  for (int t = 0; t < nt - 2; t += 2) {
    LDB(B0,0,0); SCHED; LDA(At,0,0); STAGE_A(tx, SA(1,1), 1, t + 1);
    WAIT_L(8); BAR; WAIT_L(0); MMA(0,0,At,B0); BAR; SCHED;
    LDB(B1,0,1); STAGE_B(tx, SB(0,0), 0, t + 2);
    BAR; WAIT_L(0); MMA(0,1,At,B1); BAR;
    LDA(At,0,1); STAGE_A(tx, SA(0,0), 0, t + 2);
    BAR; WAIT_L(0); MMA(1,0,At,B0); BAR; SCHED;
    STAGE_B(tx, SB(0,1), 1, t + 2);
    WAIT_V(6); BAR; MMA(1,1,At,B1); BAR;
    LDB(B0,1,0); SCHED; LDA(At,1,0); STAGE_A(tx, SA(0,1), 1, t + 2);
    WAIT_L(8); BAR; WAIT_L(0); MMA(0,0,At,B0); BAR; SCHED;
    LDB(B1,1,1); STAGE_B(tx, SB(1,0), 0, t + 3);
    BAR; WAIT_L(0); MMA(0,1,At,B1); BAR;
    LDA(At,1,1); STAGE_A(tx, SA(1,0), 0, t + 3);
    BAR; WAIT_L(0); MMA(1,0,At,B0); BAR; SCHED;
    STAGE_B(tx, SB(1,1), 1, t + 3);
    WAIT_V(6); BAR; MMA(1,1,At,B1); BAR;
  }
  int tz = threadIdx.x; asm volatile("" : "+v"(tz)); wid = tz >> 6; lane = tz & 63; wr = wid >> 2; wc = wid & 3; fr = lane & 15; fq = lane >> 4;
  { LDB(B0,0,0); WAIT_V(0); LDA(At,0,0); STAGE_A(tz, SA(1,1), 1, nt - 1);
    BAR; WAIT_L(0); MMA(0,0,At,B0); BAR;
    LDB(B1,0,1); BAR; WAIT_L(0); MMA(0,1,At,B1); BAR;
    LDA(At,0,1); WAIT_V(4); BAR; WAIT_L(0); MMA(1,0,At,B0); MMA(1,1,At,B1); BAR; }
  { LDB(B0,1,0); LDA(At,1,0); WAIT_V(2); BAR; WAIT_L(0); MMA(0,0,At,B0); BAR;
    LDB(B1,1,1); WAIT_V(0); BAR; WAIT_L(0); MMA(0,1,At,B1); BAR;
    LDA(At,1,1); BAR; WAIT_L(0); MMA(1,0,At,B0); MMA(1,1,At,B1); BAR; }
  if (wr == 0) BAR;
  __syncthreads();
}
#define EPI_COORDS int e_tz = threadIdx.x; asm volatile("" : "+v"(e_tz)); const int e_wid = e_tz >> 6, e_lane = e_tz & 63; \
    const int wr = e_wid >> 2, wc = e_wid & 3, fr = e_lane & 15, fq = e_lane >> 4; (void)wr; (void)wc; (void)fr; (void)fq;
#define EPI_LOOP _Pragma("unroll") for (int ai = 0; ai < 2; ++ai) _Pragma("unroll") for (int bj = 0; bj < 2; ++bj) \
    _Pragma("unroll") for (int m = 0; m < 4; ++m) _Pragma("unroll") for (int n = 0; n < 2; ++n)
DI bool tile_map(int u, int nrt, int nct, int& rt, int& ct) {
  const int G = gridDim.x, N = nrt * nct;
  int v = u;
  if ((G & 7) == 0) { const int r = u / G, w = u - r * G; v = r * G + (w & 7) * (G >> 3) + (w >> 3); }
  if (v >= N) return false;
  const int band = 8 * nct, g = v / band, rem = v - g * band;
  const int rows = min(8, nrt - 8 * g);
  rt = 8 * g + rem % rows; ct = rem / rows;
  return true;
}
DI int tile_slots(int N) { const int G = gridDim.x; return (N + G - 1) / G * G; }
DI void plain_rows(int brow, int& a0, int& a1, int& a2, int& a3) { int tz = threadIdx.x; asm volatile("" : "+v"(tz)); int r, c; stage_rc(tz * 16, r, c); a0 = brow + r; a1 = brow + r + 64; a2 = brow + r + 128; a3 = brow + r + 192; }
#include <utility>
struct CvtJob { const float* src; long lds_; int n0, Nreal; u16* dst; long ldd; int dmode, tk, tn; bool blk; };
DI void cvt_load(const CvtJob& J, float4 (&v)[8], int tid) {
#pragma unroll
  for (int i = 0; i < 8; ++i) {
    const int k = i * 8 + (tid >> 6), n = J.tn * 256 + (tid & 63) * 4;
    v[i] = make_float4(0.f, 0.f, 0.f, 0.f);
    if (n < J.Nreal) v[i] = *reinterpret_cast<const float4*>(J.src + (long)(J.tk * 64 + k) * J.lds_ + J.n0 + n);
  }
}
DI void cvt_to_lds(const float4 (&v)[8], float* tile, int tid) {
#pragma unroll
  for (int i = 0; i < 8; ++i) {
    const int k = i * 8 + (tid >> 6), n4 = (tid & 63) * 4;
    *reinterpret_cast<float4*>(tile + k * 260 + ((n4 + 4 * (k >> 3)) & 255)) = v[i];
  }
}
DI void cvt_store(const CvtJob& J, const float* tile, int tid) {
#pragma unroll
  for (int i = 0; i < 4; ++i) {
    const int nl = i * 64 + (tid >> 3), q = tid & 7, k8 = q * 8;
    const int n = J.tn * 256 + nl;
    const int cc = (nl + 4 * q) & 255;
    unsigned o[4];
#pragma unroll
    for (int j = 0; j < 4; ++j) o[j] = pk2(tile[(k8 + 2 * j) * 260 + cc], tile[(k8 + 2 * j + 1) * 260 + cc]);
    const int drow = J.dmode == 0 ? n : ((n >> 7) * 256 + (n & 127) + (J.dmode == 2 ? 128 : 0));
    *reinterpret_cast<uint4*>(J.dst + (J.blk ? blk_off(drow, (int)J.ldd, J.tk) : (long)drow * J.ldd + J.tk * 64) + k8) = make_uint4(o[0], o[1], o[2], o[3]);
  }
}
DI void cvt_decode(const P& p, int g, CvtJob& J) {
  char* ws = p.ws;
  J.n0 = 0; J.dmode = 0; J.blk = true;
  if (g < 1312) {
    const int l = g / 656, r = g % 656;
    char* wl = ws + OFF_W + l * WL_SIZE;
    const float* w_in = p.w_in + (size_t)l * D_ * INW;
    if (r < 192)      { J.src = w_in; J.lds_ = INW; J.Nreal = 2840; J.dst = (u16*)(wl + WL_WINT); J.ldd = 1024; J.tk = r % 16; J.tn = r / 16; }
    else if (r < 384) { J.src = w_in; J.lds_ = INW; J.n0 = 2840; J.Nreal = 3072; J.dst = (u16*)(wl + WL_WGT); J.ldd = 1024; J.tk = (r - 192) % 16; J.tn = (r - 192) / 16; }
    else if (r < 416) { J.src = p.w_sg_out + (size_t)l * 512 * 1024; J.lds_ = 1024; J.Nreal = 1024; J.dst = (u16*)(wl + WL_WSG); J.ldd = 512; J.tk = (r - 384) % 8; J.tn = (r - 384) / 8; }
    else if (r < 448) { J.src = p.w_nsa_out + (size_t)l * 512 * 1024; J.lds_ = 1024; J.Nreal = 1024; J.dst = (u16*)(wl + WL_WNSA); J.ldd = 512; J.tk = (r - 416) % 8; J.tn = (r - 416) / 8; }
    else if (r < 512) { J.src = p.w_out + (size_t)l * 1024 * 1024; J.lds_ = 1024; J.Nreal = 1024; J.dst = (u16*)(wl + WL_WOUT); J.ldd = 1024; J.tk = (r - 448) % 16; J.tn = (r - 448) / 16; }
    else if (r < 576) { J.src = p.ple_gw + (size_t)l * 1024 * 1024; J.lds_ = 1024; J.Nreal = 1024; J.dst = (u16*)(wl + WL_WPG); J.ldd = 1024; J.tk = (r - 512) % 16; J.tn = (r - 512) / 16; }
    else if (r < 592) { J.src = p.ple_pj + (size_t)l * 256 * 1024; J.lds_ = 1024; J.Nreal = 1024; J.dst = (u16*)(wl + WL_WPP); J.ldd = 256; J.tk = (r - 576) % 4; J.tn = (r - 576) / 4; }
    else if (r < 624) { J.src = p.ck_w1 + (size_t)l * 2048 * 256; J.lds_ = 256; J.Nreal = 256; J.dst = (u16*)(wl + WL_W1K); J.ldd = 2048; J.tk = r - 592; J.tn = 0; J.blk = false; }
    else              { J.src = p.cv_w1 + (size_t)l * 2048 * 256; J.lds_ = 256; J.Nreal = 256; J.dst = (u16*)(wl + WL_W1V); J.ldd = 2048; J.tk = r - 624; J.tn = 0; J.blk = false; }
  } else {
    const int g2 = g - 1312, e = g2 / 528, r = g2 % 528, which = r / 176, t = r % 176;
    char* we = ws + OFF_WFFN + (size_t)e * FFN_E_SIZE;
    J.src = which == 0 ? (e == 0 ? p.ffn_g : p.moe_g + (size_t)(e - 1) * D_ * DFF)
          : which == 1 ? (e == 0 ? p.ffn_u : p.moe_u + (size_t)(e - 1) * D_ * DFF)
                       : (e == 0 ? p.ffn_d : p.moe_d + (size_t)(e - 1) * D_ * DFF);
    if (which < 2) { J.lds_ = DFF; J.Nreal = DFF; J.dst = (u16*)we; J.ldd = 1024; J.dmode = 1 + which; J.tk = t % 16; J.tn = t / 16; }
    else           { J.lds_ = 1024; J.Nreal = 1024; J.dst = (u16*)(we + (size_t)5632 * 1024 * 2); J.ldd = DFF; J.tk = t % 44; J.tn = t / 44; }
  }
}

DI void prologue_phase(const P& p, char* smem) {
  float* tile = reinterpret_cast<float*>(smem);
  char* ws = p.ws;
  const int tid = tid_opaque();
  const long gtid = (long)blockIdx.x * NTHR + tid, gsz = (long)gridDim.x * NTHR;
  for (int u = blockIdx.x; u < 192; u += gridDim.x) {
    if (u < 128) {
      const int l = u >> 6, g = (u >> 4) & 3, nt = u & 15;
      float* sW = tile;
      float* sP = tile + 128 * 64;
      const float* pw = p.pool_w + (size_t)l * 4 * 128 * 128;
      const float* sc = p.pool_scale + (size_t)l * 512;
      const float* wo = p.w_pool_out + (size_t)l * 512 * 1024;
      u16* dst = (u16*)(ws + OFF_W + l * WL_SIZE + WL_WEFF);
      __syncthreads();
      for (int i = tid; i < 128 * 64; i += NTHR) { const int d = i >> 6, n = i & 63; sW[i] = sc[g * 128 + d] * wo[(size_t)(g * 128 + d) * 1024 + nt * 64 + n]; }
      for (int i = tid; i < 128 * 128; i += NTHR) sP[i] = pw[(size_t)g * 128 * 128 + i];
      __syncthreads();
      const int n = tid & 63, c0 = (tid >> 6) * 16;
      float a[16];
#pragma unroll
      for (int j = 0; j < 16; ++j) a[j] = 0.f;
      for (int d = 0; d < 128; ++d) {
        const float w = sW[d * 64 + n];
#pragma unroll
        for (int j = 0; j < 16; ++j) a[j] += sP[(c0 + j) * 128 + d] * w;
      }
      unsigned o[8];
#pragma unroll
      for (int j = 0; j < 8; ++j) o[j] = pk2(a[2 * j], a[2 * j + 1]);
      uint4* q = reinterpret_cast<uint4*>(dst + blk_off(nt * 64 + n, 512, (g * 128 + c0) >> 6) + ((g * 128 + c0) & 63));
      q[0] = make_uint4(o[0], o[1], o[2], o[3]); q[1] = make_uint4(o[4], o[5], o[6], o[7]);
    } else if (u < 192) {
      const int v = u - 128, l = v >> 5, kv = (v >> 4) & 1, sg = v & 15;
      {
        const float* pos = (kv == 0 ? p.ck_pos : p.cv_pos) + (size_t)l * 2048 + sg * 128;
        const float* w1 = (kv == 0 ? p.ck_w1 : p.cv_w1) + (size_t)l * 2048 * 256 + (size_t)sg * 128 * 256;
        const int c = tid & 255, hf = tid >> 8;
        float s = 0.f;
#pragma unroll 8
        for (int k = hf * 64; k < hf * 64 + 64; ++k) s += pos[k] * w1[(size_t)k * 256 + c];
        __syncthreads();
        tile[tid] = s;
        __syncthreads();
        if (tid < 256) reinterpret_cast<float*>(ws + OFF_POSB)[((l * 2 + kv) * 16 + sg) * 256 + tid] = tile[tid] + tile[tid + 256];
      }
    }
  }
  {
    const int NT = 6064, G = gridDim.x;
    int g = blockIdx.x;
    CvtJob J, Jn;
    float4 v[8];
    if (g < NT) { cvt_decode(p, g, J); cvt_load(J, v, tid); }
    while (g < NT) {
      const int gn = g + G;
      __syncthreads();
      cvt_to_lds(v, tile, tid);
      __syncthreads();
      if (gn < NT) { cvt_decode(p, gn, Jn); cvt_load(Jn, v, tid); }
      cvt_store(J, tile, tid);
      J = Jn; g = gn;
    }
    __syncthreads();
  }
  {
    const float4* src = reinterpret_cast<const float4*>(p.x);
    uint2* dst = reinterpret_cast<uint2*>(ws + OFF_XB);
    const long N4 = (long)T_ * D_ / 4;
    float4 v[4];
#pragma unroll
    for (int j = 0; j < 4; ++j) { const long ii = gtid + j * gsz; v[j] = ii < N4 ? src[ii] : make_float4(0.f, 0.f, 0.f, 0.f); }
    for (long i = gtid; i < N4; i += 4 * gsz) {
      float4 w4[4];
#pragma unroll
      for (int j = 0; j < 4; ++j) { const long ii = i + 4 * gsz + j * gsz; w4[j] = ii < N4 ? src[ii] : make_float4(0.f, 0.f, 0.f, 0.f); }
#pragma unroll
      for (int j = 0; j < 4; ++j) {
        const long ii = i + j * gsz;
        if (ii < N4) {
          const int row = (int)(ii >> 8), col = (int)(ii & 255) * 4;
          *reinterpret_cast<uint2*>((u16*)(ws + OFF_XB) + blk_off(row, 1024, col >> 6) + (col & 63)) = make_uint2(pk2(v[j].x, v[j].y), pk2(v[j].z, v[j].w));
        }
      }
#pragma unroll
      for (int j = 0; j < 4; ++j) v[j] = w4[j];
    }
  }
  {
    float* rope = reinterpret_cast<float*>(ws + OFF_ROPE);
    for (long i = gtid; i < (long)T_ * 8; i += gsz) {
      const int t = (int)(i >> 3), k = (int)(i & 7);
      const float inv = k == 0 ? 1.0f : k == 1 ? 0.1939227432012558f : k == 2 ? 0.03760603070259094f : k == 3 ? 0.007292664609849453f
                      : k == 4 ? 0.0014142135623842478f : k == 5 ? 0.00027424818836152554f : k == 6 ? 5.3182957344688475e-05f : 1.0313385246263351e-05f;
      const float ang = (float)p.pos[t] * inv;
      const double a = (double)ang;
      const double rr = a - 6.283185307179586 * rint(a * 0.15915494309189535);
      const float r = (float)rr;
      rope[t * 16 + k] = __cosf(r); rope[t * 16 + 8 + k] = __sinf(r);
    }
  }
  for (int l = 0; l < 2; ++l) {
    const float* sgw = p.sg_w + (size_t)l * 4 * 128 * 128;
    u16* d = (u16*)(ws + OFF_W + l * WL_SIZE + WL_SGW);
    for (long i = gtid; i < 4 * 128 * 128; i += gsz) { const int s = (int)(i & 127), t = (int)((i >> 7) & 127); d[i] = f2bf(s <= t ? sgw[i] : 0.f); }
  }
}
DI f32x16 mfma32(bf16x8 a, bf16x8 b, f32x16 c) { return __builtin_amdgcn_mfma_f32_32x32x16_bf16(a, b, c, 0, 0, 0); }
DI f32x4  mfma16(bf16x8 a, bf16x8 b, f32x4 c)  { return __builtin_amdgcn_mfma_f32_16x16x32_bf16(a, b, c, 0, 0, 0); }

DI void ph1_proj(const P& p, int l, char* smem) {
  char* ws = p.ws;
  const u16* XB = (const u16*)(ws + OFF_XB);
  const u16* WinT = (const u16*)(ws + OFF_W + l * WL_SIZE + WL_WINT);
  const float* rope = (const float*)(ws + OFF_ROPE);
  for (int u = blockIdx.x; u < tile_slots(128 * 12); u += gridDim.x) {
    int rt, ct; if (!tile_map(u, 128, 12, rt, ct)) continue;
    const int brow = rt * 256;
    int a0, a1, a2, a3; plain_rows(brow, a0, a1, a2, a3);
    f32x4 acc[2][2][4][2];
    gemm256<true, true>(XB, 1024, a0, a1, a2, a3, WinT, 1024, ct * 256, 16, (u16*)smem, acc);
    EPI_COORDS
    const int b = brow / S_, s0 = brow % S_;
    if (ct >= 6 && ct < 11 && (wc & 1) == 0) {
#pragma unroll
      for (int ai = 0; ai < 2; ++ai) {
        float cs[4][4], sn[4][4];
#pragma unroll
        for (int m = 0; m < 4; ++m)
#pragma unroll
          for (int j = 0; j < 4; ++j) {
            const size_t row = (size_t)(brow + ai * 128 + wr * 64 + m * 16 + fq * 4 + j);
            cs[m][j] = rope[row * 16 + (fr & 7)]; sn[m][j] = rope[row * 16 + 8 + (fr & 7)];
          }
#pragma unroll
        for (int bj = 0; bj < 2; ++bj) {
          if (ct < 8 || bj == 0) {
#pragma unroll
            for (int m = 0; m < 4; ++m)
#pragma unroll
              for (int j = 0; j < 4; ++j) {
                const float v = acc[ai][bj][m][0][j], pv = __shfl_xor(v, 8);
                acc[ai][bj][m][0][j] = fr < 8 ? v * cs[m][j] - pv * sn[m][j] : v * cs[m][j] + pv * sn[m][j];
              }
          }
        }
      }
    }
    if (ct < 6) {
      u16* dst = (u16*)(ws + (ct < 2 ? RB_A : ct < 4 ? RB_GU : RB_GV));
      u16* AH = (u16*)(ws + OFF_AH);
      const int cb = (ct & 1) * 256;
      EPI_LOOP {
        const int col = cb + bj * 128 + wc * 32 + n * 16 + fr;
#pragma unroll
        for (int j = 0; j < 4; ++j) {
          const int row = brow + ai * 128 + wr * 64 + m * 16 + fq * 4 + j;
          float v = acc[ai][bj][m][n][j];
          if (ct >= 2) v = fgelu(v);
          const u16 hv = f2bf(v);
          dst[(size_t)row * 512 + col] = hv;
          if (ct < 2 && wr == 1 && m == 3 && (fq * 4 + j) >= 1) AH[((size_t)(row >> 7) * 16 + (fq * 4 + j)) * 512 + col] = hv;
        }
      }
    } else if (ct < 8) {
      u16* Q = (u16*)(ws + RB_Q);
      EPI_LOOP {
        const int head = (ct - 6) * 4 + bj * 2 + (wc >> 1), d = (wc & 1) * 32 + n * 16 + fr;
#pragma unroll
        for (int j = 0; j < 4; ++j) {
          const int row = brow + ai * 128 + wr * 64 + m * 16 + fq * 4 + j;
          const float v = acc[ai][bj][m][n][j];
          Q[(size_t)row * 512 + head * 64 + d] = f2bf(v * 0.18033688011112042f);
        }
      }
    } else if (ct < 11) {
      u16* Kd = (u16*)(ws + (ct == 8 ? RB_KC : ct == 9 ? RB_KS : RB_KW));
      u16* Vd = (u16*)(ws + (ct == 8 ? RB_VC : ct == 9 ? RB_VST : RB_VWT));
      EPI_LOOP {
        const int head = wc >> 1, d = (wc & 1) * 32 + n * 16 + fr;
        const int bh = b * 2 + head;
        const int sl = s0 + ai * 128 + wr * 64 + m * 16 + fq * 4;
        if (bj == 0) {
#pragma unroll
          for (int j = 0; j < 4; ++j) {
            const float v = acc[ai][bj][m][n][j];
            Kd[((size_t)bh * S_ + sl + j) * 64 + d] = f2bf(v);
          }
        } else if (ct == 8) {
#pragma unroll
          for (int j = 0; j < 4; ++j) Vd[((size_t)bh * S_ + sl + j) * 64 + d] = f2bf(acc[ai][bj][m][n][j]);
        } else {
          const int blk = sl >> 6;
          const int pos = ct == 9 ? (32 * (m >> 1) + 8 * fq + 4 * (m & 1)) : (16 * m + 8 * (fq & 1) + 4 * (fq >> 1));
          const f32x4 v = acc[ai][bj][m][n];
          *reinterpret_cast<uint2*>(Vd + (((size_t)bh * 256 + blk) * 64 + d) * 64 + pos) = make_uint2(pk2(v[0], v[1]), pk2(v[2], v[3]));
        }
      }
    } else {
      float* NG = (float*)(ws + OFF_NG);
      EPI_LOOP {
        if (bj == 0 && wc == 0) {
          const int col = n * 16 + fr;
          if (col < 24) {
#pragma unroll
            for (int j = 0; j < 4; ++j) {
              const int row = brow + ai * 128 + wr * 64 + m * 16 + fq * 4 + j;
              NG[(size_t)row * 24 + col] = fsigmoid(acc[ai][bj][m][n][j]);
            }
          }
        }
      }
    }
  }
}

DI void chunk_unit(const P& p, int l, int c, char* smem) {
  char* ws = p.ws;
  int tid_ = tid_opaque(); asm volatile("" : "+v"(tid_));
  const int tid = tid_, w = tid >> 6, lane = tid & 63;
  u16* A_ = (u16*)(ws + RB_A);
  const u16* AH = (const u16*)(ws + OFF_AH);
  u16* GU = (u16*)(ws + RB_GU);
  const u16* GV = (const u16*)(ws + RB_GV);
  const int R0 = c * 128, sseq0 = R0 % S_;
  {
    const int wsz = 2 << (lane >> 4);
    uint4* stg = reinterpret_cast<uint4*>(smem);
    const bool has_halo = sseq0 != 0;
#pragma unroll
    for (int i = 0; i < 18; ++i) {
      const int rl = w + 8 * i;
      if (rl < 143) {
        const int rr = rl - 15;
        uint4 v = make_uint4(0u, 0u, 0u, 0u);
        if (rr >= 0) v = *reinterpret_cast<const uint4*>(A_ + (size_t)(R0 + rr) * 512 + lane * 8);
        else if (has_halo) v = *reinterpret_cast<const uint4*>(AH + ((size_t)(c - 1) * 16 + 16 + rr) * 512 + lane * 8);
        stg[rl * 64 + lane] = v;
      }
    }
    __syncthreads();
#pragma unroll 1
    for (int ti = 0; ti < 16; ++ti) {
      const int tl = 16 * w + ti, sq = sseq0 + tl;
      float s8[8], cur[8];
#pragma unroll
      for (int e = 0; e < 8; ++e) { s8[e] = 0.f; cur[e] = 0.f; }
      const int nj = min(sq + 1, wsz);
      for (int j = 0; j < nj; ++j) {
        const uint4 raw = stg[(tl + 15 - j) * 64 + lane];
        const unsigned rw[4] = {raw.x, raw.y, raw.z, raw.w};
#pragma unroll
        for (int e = 0; e < 4; ++e) {
          const float lo = bflo(rw[e]), hi = bfhi(rw[e]);
          s8[2 * e] += lo; s8[2 * e + 1] += hi;
          if (j == 0) { cur[2 * e] = lo; cur[2 * e + 1] = hi; }
        }
      }
      const float inv = 1.f / (float)nj;
      *reinterpret_cast<uint4*>((u16*)(ws + RB_DB) + blk_off(R0 + tl, 512, lane >> 3) + (lane & 7) * 8) =
          make_uint4(pk2(s8[0] * inv - cur[0], s8[1] * inv - cur[1]), pk2(s8[2] * inv - cur[2], s8[3] * inv - cur[3]),
                     pk2(s8[4] * inv - cur[4], s8[5] * inv - cur[5]), pk2(s8[6] * inv - cur[6], s8[7] * inv - cur[7]));
    }
  }
  float* st_mu = reinterpret_cast<float*>(smem);
  float* st_rs = st_mu + 128;
  u16* VT = reinterpret_cast<u16*>(smem + 1024);
  const float* lg = p.sg_ln_g + (size_t)l * 512;
  const float* lb = p.sg_ln_b + (size_t)l * 512;
  const float* sgb = p.sg_b + (size_t)l * 512;
  const u16* SGW = (const u16*)(ws + OFF_W + l * WL_SIZE + WL_SGW);
  __syncthreads();
#pragma unroll 1
  for (int t4 = 0; t4 < 16; t4 += 4) {
    uint4 raw4[4];
#pragma unroll
    for (int q = 0; q < 4; ++q) raw4[q] = *reinterpret_cast<const uint4*>(GV + (size_t)(R0 + 16 * w + t4 + q) * 512 + lane * 8);
#pragma unroll
    for (int q = 0; q < 4; ++q) {
      const int tl = 16 * w + t4 + q;
      const unsigned rw[4] = {raw4[q].x, raw4[q].y, raw4[q].z, raw4[q].w};
      float x[8];
#pragma unroll
      for (int e = 0; e < 4; ++e) { x[2 * e] = bflo(rw[e]); x[2 * e + 1] = bfhi(rw[e]); }
      float s = 0.f;
#pragma unroll
      for (int e = 0; e < 8; ++e) s += x[e];
      const float mu = wave_sum(s) * (1.f / 512.f);
      float v = 0.f;
#pragma unroll
      for (int e = 0; e < 8; ++e) { const float d = x[e] - mu; v += d * d; }
      const float var = wave_sum(v) * (1.f / 512.f);
      if (lane == 0) { st_mu[tl] = mu; st_rs[tl] = rsqrtf(var + 1e-5f); }
    }
  }
  __syncthreads();
  const int fr = lane & 15, fq = lane >> 4;
#pragma unroll 1
  for (int g = 0; g < 4; ++g) {
    const int nks = (w >> 1) + 1;
    bf16x8 afr[4];
#pragma unroll
    for (int ks = 0; ks < 4; ++ks)
      afr[ks] = *reinterpret_cast<const bf16x8*>(SGW + ((size_t)(g * 128 + 16 * w + fr)) * 128 + 32 * (ks < nks ? ks : 0) + 8 * fq);
    {
      const int sp = tid >> 3, cr = (tid & 7) * 16;
      const int sA = 2 * sp, sB = 2 * sp + 1;
      const float muA = st_mu[sA], rsA = st_rs[sA], muB = st_mu[sB], rsB = st_rs[sB];
      const uint4* pa = reinterpret_cast<const uint4*>(GV + (size_t)(R0 + sA) * 512 + g * 128 + cr);
      const uint4* pb = reinterpret_cast<const uint4*>(GV + (size_t)(R0 + sB) * 512 + g * 128 + cr);
      const uint4 ra0 = pa[0], ra1 = pa[1], rb0 = pb[0], rb1 = pb[1];
      const unsigned ua[8] = {ra0.x, ra0.y, ra0.z, ra0.w, ra1.x, ra1.y, ra1.z, ra1.w};
      const unsigned ub[8] = {rb0.x, rb0.y, rb0.z, rb0.w, rb1.x, rb1.y, rb1.z, rb1.w};
#pragma unroll
      for (int e = 0; e < 8; ++e) {
        const int c0 = cr + 2 * e;
        const float g0 = lg[g * 128 + c0], g1 = lg[g * 128 + c0 + 1], b0 = lb[g * 128 + c0], b1 = lb[g * 128 + c0 + 1];
        const float a0 = (bflo(ua[e]) - muA) * rsA * g0 + b0, a1 = (bfhi(ua[e]) - muA) * rsA * g1 + b1;
        const float q0 = (bflo(ub[e]) - muB) * rsB * g0 + b0, q1 = (bfhi(ub[e]) - muB) * rsB * g1 + b1;
        *reinterpret_cast<unsigned*>(VT + (size_t)c0 * 136 + sA) = pk2(a0, q0);
        *reinterpret_cast<unsigned*>(VT + (size_t)(c0 + 1) * 136 + sA) = pk2(a1, q1);
      }
    }
    __syncthreads();
    f32x4 acc[8];
#pragma unroll
    for (int nt = 0; nt < 8; ++nt) acc[nt] = f32x4{0.f, 0.f, 0.f, 0.f};
#pragma unroll
    for (int ks = 0; ks < 4; ++ks) {
      if (ks < nks) {
      const bf16x8 a = afr[ks];
#pragma unroll
      for (int nt = 0; nt < 8; ++nt) {
        const bf16x8 bb = *reinterpret_cast<const bf16x8*>(VT + (size_t)(16 * nt + fr) * 136 + 32 * ks + 8 * fq);
        acc[nt] = mfma16(a, bb, acc[nt]);
      }
      }
    }
    {
      u16 guv[8][4]; float sbv[4];
#pragma unroll
      for (int j = 0; j < 4; ++j) sbv[j] = sgb[g * 128 + 16 * w + 4 * fq + j];
#pragma unroll
      for (int nt = 0; nt < 8; ++nt)
#pragma unroll
        for (int j = 0; j < 4; ++j) guv[nt][j] = GU[(size_t)(R0 + 16 * w + 4 * fq + j) * 512 + g * 128 + 16 * nt + fr];
#pragma unroll
      for (int nt = 0; nt < 8; ++nt)
#pragma unroll
        for (int j = 0; j < 4; ++j) {
          const int t = 16 * w + 4 * fq + j, cc = g * 128 + 16 * nt + fr;
          ((u16*)(ws + RB_YB))[blk_off(R0 + t, 512, cc >> 6) + (cc & 63)] = f2bf(bf2f(guv[nt][j]) * (acc[nt][j] + sbv[j]));
        }
    }
    __syncthreads();
  }
}

DI void ph2_mix(const P& p, int l, char* smem) {
  char* ws = p.ws;
  for (int u = blockIdx.x; u < 64 + 256; u += gridDim.x) {
    if (u < 64) {
      const int kv = u >> 5, split = (u >> 4) & 1, rtile = u & 15, brow = rtile * 256;
      const u16* A = (const u16*)(ws + (kv ? RB_VC : RB_KC)) + split * 1024;
      const u16* Bt = (const u16*)(ws + OFF_W + l * WL_SIZE + (kv ? WL_W1V : WL_W1K)) + split * 1024;
      int a0, a1, a2, a3; plain_rows(brow, a0, a1, a2, a3);
      f32x4 acc[2][2][4][2];
      gemm256(A, 1024, a0, a1, a2, a3, Bt, 2048, 0, 16, (u16*)smem, acc);
      EPI_COORDS
      float* HID = (float*)(ws + RB_HID) + (size_t)(kv * 2 + split) * 4096 * 256;
      EPI_LOOP {
        const int col = bj * 128 + wc * 32 + n * 16 + fr;
#pragma unroll
        for (int j = 0; j < 4; ++j) {
          const int row = brow + ai * 128 + wr * 64 + m * 16 + fq * 4 + j;
          HID[(size_t)row * 256 + col] = acc[ai][bj][m][n][j];
        }
      }
    } else {
      chunk_unit(p, l, u - 64, smem);
    }
  }
}

DI void ph2b_cmp2(const P& p, int l, char* smem) {
  char* ws = p.ws;
  float* sH = reinterpret_cast<float*>(smem);
  float* sW2 = sH + 16 * 256;
  const int tid = tid_opaque();
  const float* posb = (const float*)(ws + OFF_POSB);
  for (int u = blockIdx.x; u < 512; u += gridDim.x) {
    const int kv = u >> 8, rb = u & 255;
    const float* w2 = (kv ? p.cv_w2 : p.ck_w2) + (size_t)l * 256 * 64;
    const float* H0 = (const float*)(ws + RB_HID) + (size_t)(kv * 2 + 0) * 4096 * 256;
    const float* H1 = (const float*)(ws + RB_HID) + (size_t)(kv * 2 + 1) * 4096 * 256;
    __syncthreads();
    for (int i = tid; i < 256 * 64; i += NTHR) sW2[i] = w2[i];
    for (int i = tid; i < 16 * 256; i += NTHR) {
      const size_t gi = (size_t)(rb * 16) * 256 + i;
      float pb = 0.f;
#pragma unroll
      for (int sg = 0; sg < 16; ++sg) pb += posb[((l * 2 + kv) * 16 + sg) * 256 + (i & 255)];
      sH[i] = fgelu(H0[gi] + H1[gi] + pb);
    }
    __syncthreads();
    const int row = tid >> 5, e2 = (tid & 31) * 2;
    float o0 = 0.f, o1 = 0.f;
    for (int c = 0; c < 256; ++c) { const float h = sH[row * 256 + c]; o0 += h * sW2[c * 64 + e2]; o1 += h * sW2[c * 64 + e2 + 1]; }
    const int R = rb * 16 + row, bh = R >> 10, i = R & 1023;
    if (kv == 0) {
      *reinterpret_cast<unsigned*>((u16*)(ws + OFF_KCMP) + ((size_t)bh * 1024 + i) * 64 + e2) = pk2(o0, o1);
    } else {
      const int key = i & 63, pos = 16 * (key >> 4) + 8 * ((key >> 2) & 1) + 4 * ((key >> 3) & 1) + (key & 3);
      u16* vt = (u16*)(ws + OFF_VCMPT) + ((size_t)(bh * 16 + (i >> 6)) * 64) * 64;
      vt[(size_t)e2 * 64 + pos] = f2bf(o0); vt[(size_t)(e2 + 1) * 64 + pos] = f2bf(o1);
    }
  }
}
DI int crow16(int i, int h) { return (i & 3) + 8 * (i >> 2) + 4 * h; }
DI bf16x8 pack8(float a0, float a1, float a2, float a3, float a4, float a5, float a6, float a7) {
  u32x4 r; r[0] = pk2(a0, a1); r[1] = pk2(a2, a3); r[2] = pk2(a4, a5); r[3] = pk2(a6, a7); return __builtin_bit_cast(bf16x8, r);
}
constexpr int ATT_REP_CMP1 = 1, ATT_REP_TOPK = 1, ATT_REP_WIN = 1, ATT_REP_SLC = 1;
constexpr int ATT_IMP = 0, ATT_RING = 0, ATT_SK = 66048, ATT_SV = ATT_SK + 9216,
              ATT_MSK = 131072, ATT_ULIST = ATT_MSK + 2048, ATT_UCNT = ATT_ULIST + 512, ATT_END = ATT_UCNT + 64;
static_assert(ATT_END <= 147456, "attention LDS map overflows");

DI uint4 att_gload(const u16* gsrc, int tid) { return *reinterpret_cast<const uint4*>(gsrc + (tid >> 3) * 64 + (tid & 7) * 8); }
DI void att_lstore(u16* sdst, uint4 v, int tid) { *reinterpret_cast<uint4*>(sdst + (tid >> 3) * 72 + (tid & 7) * 8) = v; }

DI void ph3_attn(const P& p, int l, char* smem) {
  char* ws = p.ws;
  const int tid = tid_opaque(), w = tid >> 6, lane = tid & 63;
  const int r = lane & 31, h = lane >> 5, ql = r >> 2, g = r & 3;
  u16* sK = reinterpret_cast<u16*>(smem + ATT_SK);
  u16* sV = reinterpret_cast<u16*>(smem + ATT_SV);
  float* imp = reinterpret_cast<float*>(smem + ATT_IMP);
  unsigned char* msk = reinterpret_cast<unsigned char*>(smem + ATT_MSK) + w * 256;
  unsigned short* ulist = reinterpret_cast<unsigned short*>(smem + ATT_ULIST);
  int* ucnt = reinterpret_cast<int*>(smem + ATT_UCNT);
  char* ring = smem + ATT_RING;
  const u16* Q = (const u16*)(ws + RB_Q);
  const u16* KCMP = (const u16*)(ws + OFF_KCMP);
  const u16* VCMPT = (const u16*)(ws + OFF_VCMPT);
  const u16* KS = (const u16*)(ws + RB_KS);
  const u16* VST = (const u16*)(ws + RB_VST);
  const u16* KW = (const u16*)(ws + RB_KW);
  const u16* VWT = (const u16*)(ws + RB_VWT);
  const float* NG = (const float*)(ws + OFF_NG);
  u16* O = (u16*)(ws + RB_O);

  for (int u = blockIdx.x; u < 1024; u += gridDim.x) {
    const int bh = u >> 8, wq = u & 255, qt = (bh & 1) ? 255 - wq : wq;
    const int b = bh >> 1, hkv = bh & 1, q0 = qt * 64;
    const int t = q0 + 8 * w + ql, head = hkv * 4 + g;
    const size_t tok = (size_t)b * S_ + t;
    bf16x8 Qf[4];
#pragma unroll
    for (int ks = 0; ks < 4; ++ks) Qf[ks] = *reinterpret_cast<const bf16x8*>(Q + tok * 512 + head * 64 + 16 * ks + 8 * h);
    const float gc = NG[tok * 24 + head * 3 + 0], gw = NG[tok * 24 + head * 3 + 2];
    __syncthreads();
    for (int i = tid; i < 64 * 257; i += NTHR) imp[i] = 0.f;
    reinterpret_cast<unsigned*>(smem + ATT_MSK)[tid] = 0u;
    __syncthreads();

    const int nk = q0 / 16 + 3, ntile = (nk + 63) >> 6;
    float m1 = -1e30f, l1 = 0.f;
#pragma unroll 1
    for (int rep = 0; rep < ATT_REP_CMP1; ++rep) { m1 = -1e30f; l1 = 0.f;
    uint4 rk = att_gload(KCMP + ((size_t)bh * 1024) * 64, tid);
    for (int kt = 0; kt < ntile; ++kt) {
      __syncthreads();
      att_lstore(sK, rk, tid);
      rk = att_gload(KCMP + ((size_t)bh * 1024 + 64 * (kt + 1 < ntile ? kt + 1 : kt)) * 64, tid);
      __syncthreads();
#pragma unroll
      for (int kh = 0; kh < 2; ++kh) {
        f32x16 sa;
#pragma unroll
        for (int i = 0; i < 16; ++i) sa[i] = 0.f;
#pragma unroll
        for (int ks = 0; ks < 4; ++ks) sa = mfma32(*reinterpret_cast<const bf16x8*>(sK + (32 * kh + r) * 72 + 16 * ks + 8 * h), Qf[ks], sa);
        float tm = -1e30f;
#pragma unroll
        for (int i = 0; i < 16; ++i) { const int key = 64 * kt + 32 * kh + crow16(i, h); if (16 * key + 31 <= t) tm = fmaxf(tm, sa[i]); }
        const float mn = fmaxf(m1, tm);
        float sum = 0.f;
#pragma unroll
        for (int i = 0; i < 16; ++i) { const int key = 64 * kt + 32 * kh + crow16(i, h); if (16 * key + 31 <= t) sum += __builtin_amdgcn_exp2f(sa[i] - mn); }
        l1 = l1 * __builtin_amdgcn_exp2f(m1 - mn) + sum; m1 = mn;
      }
    }
    }
    float Mx, invL;
    {
      const float mo = __shfl_xor(m1, 32), lo = __shfl_xor(l1, 32);
      Mx = fmaxf(m1, mo);
      const float L = l1 * __builtin_amdgcn_exp2f(m1 - Mx) + lo * __builtin_amdgcn_exp2f(mo - Mx);
      invL = L > 0.f ? 1.f / L : 0.f;
    }
    f32x16 fin[2];
    {
      f32x16 oc[2];
#pragma unroll
      for (int i = 0; i < 16; ++i) { oc[0][i] = 0.f; oc[1][i] = 0.f; }
      uint4 rk2 = att_gload(KCMP + ((size_t)bh * 1024) * 64, tid), rv2 = att_gload(VCMPT + ((size_t)(bh * 16) * 64) * 64, tid);
      for (int kt = 0; kt < ntile; ++kt) {
        __syncthreads();
        att_lstore(sK, rk2, tid); att_lstore(sV, rv2, tid);
        { const int kn = kt + 1 < ntile ? kt + 1 : kt;
          rk2 = att_gload(KCMP + ((size_t)bh * 1024 + 64 * kn) * 64, tid); rv2 = att_gload(VCMPT + ((size_t)(bh * 16 + kn) * 64) * 64, tid); }
        __syncthreads();
#pragma unroll
        for (int kh = 0; kh < 2; ++kh) {
          f32x16 sa;
#pragma unroll
          for (int i = 0; i < 16; ++i) sa[i] = 0.f;
#pragma unroll
          for (int ks = 0; ks < 4; ++ks) sa = mfma32(*reinterpret_cast<const bf16x8*>(sK + (32 * kh + r) * 72 + 16 * ks + 8 * h), Qf[ks], sa);
          float pp[16];
#pragma unroll
          for (int i = 0; i < 16; ++i) { const int key = 64 * kt + 32 * kh + crow16(i, h); pp[i] = (16 * key + 31 <= t) ? __builtin_amdgcn_exp2f(sa[i] - Mx) * invL : 0.f; }
#pragma unroll
          for (int a = 0; a < 4; ++a) {
            float v = 2.f * (pp[4 * a] + pp[4 * a + 1] + pp[4 * a + 2]) + pp[4 * a + 3], wv = pp[4 * a + 3];
            v += __uint_as_float(dpp_mov<0xB1>(__float_as_uint(v))); v += __uint_as_float(dpp_mov<0x4E>(__float_as_uint(v)));
            wv += __uint_as_float(dpp_mov<0xB1>(__float_as_uint(wv))); wv += __uint_as_float(dpp_mov<0x4E>(__float_as_uint(wv)));
            const int blk = 16 * kt + 8 * kh + 2 * a + h;
            if (g == a) { atomicAdd(&imp[(8 * w + ql) * 257 + blk], v); if (blk + 1 < 256) atomicAdd(&imp[(8 * w + ql) * 257 + blk + 1], wv); }
          }
#pragma unroll
          for (int s2 = 0; s2 < 2; ++s2) {
            const bf16x8 pb = pack8(pp[8 * s2], pp[8 * s2 + 1], pp[8 * s2 + 2], pp[8 * s2 + 3], pp[8 * s2 + 4], pp[8 * s2 + 5], pp[8 * s2 + 6], pp[8 * s2 + 7]);
#pragma unroll
            for (int dt = 0; dt < 2; ++dt)
              oc[dt] = mfma32(*reinterpret_cast<const bf16x8*>(sV + (32 * dt + r) * 72 + 32 * kh + 16 * s2 + 8 * h), pb, oc[dt]);
          }
        }
      }
#pragma unroll
      for (int i = 0; i < 16; ++i) { fin[0][i] = gc * oc[0][i]; fin[1][i] = gc * oc[1][i]; }
    }
    if (qt <= 15) {
      if (lane <= qt) msk[lane] = 0xff;
    } else {
      if (lane == 0) { msk[0] = 0xff; msk[qt - 1] = 0xff; msk[qt] = 0xff; }
      const unsigned long long lt_mask = (1ull << lane) - 1ull;
#pragma unroll 1
      for (int rep = 0; rep < ATT_REP_TOPK; ++rep) {
        unsigned sel8[4] = {0u, 0u, 0u, 0u};
#pragma unroll 1
        for (int qi = 0; qi < 8; ++qi) {
          unsigned key[4];
#pragma unroll
          for (int k = 0; k < 4; ++k) {
            const int blk = lane + 64 * k;
            const bool ok = blk >= 1 && blk <= qt - 2;
            key[k] = ok ? __float_as_uint(imp[(8 * w + qi) * 257 + blk]) + 1u : 0u;
          }
          unsigned thr = 0u;
#pragma unroll 1
          for (int bb = 30; bb >= 0; --bb) {
            const unsigned cand = thr | (1u << bb);
            const int cnt = __popcll(__ballot(key[0] >= cand)) + __popcll(__ballot(key[1] >= cand)) +
                            __popcll(__ballot(key[2] >= cand)) + __popcll(__ballot(key[3] >= cand));
            if (cnt >= 13) thr = cand;
          }
          const int cgt = __popcll(__ballot(key[0] > thr)) + __popcll(__ballot(key[1] > thr)) +
                          __popcll(__ballot(key[2] > thr)) + __popcll(__ballot(key[3] > thr));
          const int need = 13 - cgt;
          int before = 0;
#pragma unroll
          for (int k = 0; k < 4; ++k) {
            const bool eq = key[k] == thr;
            const unsigned long long em = __ballot(eq);
            const int rank = before + __popcll(em & lt_mask);
            if (key[k] > thr || (eq && rank < need)) sel8[k] |= 1u << qi;
            before += __popcll(em);
          }
        }
#pragma unroll
        for (int k = 0; k < 4; ++k) if (sel8[k]) msk[lane + 64 * k] |= (unsigned char)sel8[k];
      }
    }
    {
      float mw = -1e30f, lw = 0.f;
      f32x16 ow[2];
#pragma unroll
      for (int i = 0; i < 16; ++i) { ow[0][i] = 0.f; ow[1][i] = 0.f; }
      const int kt_lo = qt - 8 > 0 ? qt - 8 : 0;
#pragma unroll 1
      for (int rep = 0; rep < ATT_REP_WIN; ++rep) { mw = -1e30f; lw = 0.f;
#pragma unroll
      for (int i = 0; i < 16; ++i) { ow[0][i] = 0.f; ow[1][i] = 0.f; }
      uint4 rk3 = att_gload(KW + ((size_t)bh * S_ + (size_t)kt_lo * 64) * 64, tid), rv3 = att_gload(VWT + ((size_t)(bh * 256 + kt_lo) * 64) * 64, tid);
      for (int kt = kt_lo; kt <= qt; ++kt) {
        __syncthreads();
        att_lstore(sK, rk3, tid); att_lstore(sV, rv3, tid);
        { const int kn = kt < qt ? kt + 1 : kt;
          rk3 = att_gload(KW + ((size_t)bh * S_ + (size_t)kn * 64) * 64, tid); rv3 = att_gload(VWT + ((size_t)(bh * 256 + kn) * 64) * 64, tid); }
        __syncthreads();
        f32x16 sa[2];
#pragma unroll
        for (int kh = 0; kh < 2; ++kh) {
#pragma unroll
          for (int i = 0; i < 16; ++i) sa[kh][i] = 0.f;
#pragma unroll
          for (int ks = 0; ks < 4; ++ks) sa[kh] = mfma32(*reinterpret_cast<const bf16x8*>(sK + (32 * kh + r) * 72 + 16 * ks + 8 * h), Qf[ks], sa[kh]);
        }
        float tm = -1e30f;
#pragma unroll
        for (int kh = 0; kh < 2; ++kh)
#pragma unroll
          for (int i = 0; i < 16; ++i) {
            const int key = 64 * kt + 32 * kh + crow16(i, h);
            const bool ok = key <= t && t - key < 512;
            sa[kh][i] = ok ? sa[kh][i] : -INFINITY;
            tm = fmaxf(tm, sa[kh][i]);
          }
        tm = fmax_x32(tm);
        const float mn = fmaxf(mw, tm), al = __builtin_amdgcn_exp2f(mw - mn);
        mw = mn; lw *= al;
#pragma unroll
        for (int i = 0; i < 16; ++i) { ow[0][i] *= al; ow[1][i] *= al; }
        float sum = 0.f;
#pragma unroll
        for (int kh = 0; kh < 2; ++kh)
#pragma unroll
          for (int i = 0; i < 16; ++i) { const float e = __builtin_amdgcn_exp2f(sa[kh][i] - mn); sa[kh][i] = e; sum += e; }
        lw += sum;
#pragma unroll
        for (int kh = 0; kh < 2; ++kh)
#pragma unroll
          for (int s2 = 0; s2 < 2; ++s2) {
            const bf16x8 pb = pack8(sa[kh][8 * s2], sa[kh][8 * s2 + 1], sa[kh][8 * s2 + 2], sa[kh][8 * s2 + 3], sa[kh][8 * s2 + 4], sa[kh][8 * s2 + 5], sa[kh][8 * s2 + 6], sa[kh][8 * s2 + 7]);
#pragma unroll
            for (int dt = 0; dt < 2; ++dt)
              ow[dt] = mfma32(*reinterpret_cast<const bf16x8*>(sV + (32 * dt + r) * 72 + 32 * kh + 16 * s2 + 8 * h), pb, ow[dt]);
          }
      }
      }
      lw = fsum_x32(lw);
      const float scl = gw / lw;
#pragma unroll
      for (int i = 0; i < 16; ++i) { fin[0][i] += scl * ow[0][i]; fin[1][i] += scl * ow[1][i]; }
    }
    __syncthreads();
    int urank = 0; bool uhas = false;
    const int tidc = tid_opaque(), wc_ = tidc >> 6, lanec = tidc & 63;
    if (tidc < 256) {
      unsigned any = 0;
#pragma unroll
      for (int ww = 0; ww < 8; ++ww) any |= reinterpret_cast<unsigned char*>(smem + ATT_MSK)[ww * 256 + tidc];
      uhas = any != 0;
      const unsigned long long bal = __ballot(uhas);
      if (lanec == 0) reinterpret_cast<int*>(smem + ATT_UCNT)[wc_] = __popcll(bal);
      urank = __popcll(bal & ((1ull << lanec) - 1ull));
    }
    __syncthreads();
    const int nU = ucnt[0] + ucnt[1] + ucnt[2] + ucnt[3];
    if (tidc < 256 && uhas) {
      int base = 0;
#pragma unroll
      for (int v = 0; v < 3; ++v) if (v < wc_) base += ucnt[v];
      ulist[base + urank] = (unsigned short)tidc;
    }
    __syncthreads();
    {
      const int tid2 = tid_opaque(), fr = tid2 & 15, fq = (tid2 >> 4) & 3, slot = fr >> 2, gg = fr & 3, w2 = tid2 >> 6;
      const unsigned char* msk2 = reinterpret_cast<const unsigned char*>(smem + ATT_MSK) + w2 * 256;
      const int ld_s = tid2 >> 8, ld_which = (tid2 >> 7) & 1, ld_row = (tid2 & 127) >> 1, ld_half = tid2 & 1;
      const int nchunk = (nU + 3) >> 2;
      uint4 sg0, sg1, sg2, sg3;
#define SLC_GLOAD(c_, hf_) do { int idx_ = 4 * (c_) + 2 * (hf_) + ld_s; idx_ = idx_ < nU ? idx_ : nU - 1; const int blk_ = ulist[idx_]; \
          const uint4* src_ = reinterpret_cast<const uint4*>(ld_which ? VST + ((size_t)(bh * 256 + blk_) * 64 + ld_row) * 64 + ld_half * 32 \
                                                                     : KS + ((size_t)bh * S_ + (size_t)blk_ * 64 + ld_row) * 64 + ld_half * 32); \
          sg0 = src_[0]; sg1 = src_[1]; sg2 = src_[2]; sg3 = src_[3]; } while (0)
#define SLC_LSTORE(c_, hf_) do { char* dst_ = smem + ATT_RING + (((c_) & 1) * 4 + 2 * (hf_) + ld_s) * 16384 + ld_which * 8192 + ld_row * 128; \
          const int sw_ = ld_row & 7, cb_ = ld_half * 4; \
          *reinterpret_cast<uint4*>(dst_ + (((cb_ + 0) ^ sw_) << 4)) = sg0; *reinterpret_cast<uint4*>(dst_ + (((cb_ + 1) ^ sw_) << 4)) = sg1; \
          *reinterpret_cast<uint4*>(dst_ + (((cb_ + 2) ^ sw_) << 4)) = sg2; *reinterpret_cast<uint4*>(dst_ + (((cb_ + 3) ^ sw_) << 4)) = sg3; } while (0)
      bf16x8 qA[2], qB[2];
#pragma unroll
      for (int ks = 0; ks < 2; ++ks) {
        qA[ks] = *reinterpret_cast<const bf16x8*>(Q + ((size_t)b * S_ + q0 + 8 * w2 + slot) * 512 + (hkv * 4 + gg) * 64 + 32 * ks + 8 * fq);
        qB[ks] = *reinterpret_cast<const bf16x8*>(Q + ((size_t)b * S_ + q0 + 8 * w2 + slot + 4) * 512 + (hkv * 4 + gg) * 64 + 32 * ks + 8 * fq);
      }
      f32x4 osA[4], osB[4];
#pragma unroll
      for (int dt = 0; dt < 4; ++dt) { osA[dt] = f32x4{0.f, 0.f, 0.f, 0.f}; osB[dt] = f32x4{0.f, 0.f, 0.f, 0.f}; }
      float mA = -1e30f, lA = 0.f, mB = -1e30f, lB = 0.f;
      auto step = [&](f32x4 (&os)[4], float& mrun, float& lrun, const bf16x8 (&qfr)[2], int qbase, const char* Kl, const char* Vl, int jb, int bits) {
        const bool act = (bits >> slot) & 1;
        const float si = act ? 0.f : -INFINITY;
        f32x4 sc[4];
#pragma unroll
        for (int m = 0; m < 4; ++m) {
          sc[m] = f32x4{si, si, si, si};
#pragma unroll
          for (int ks = 0; ks < 2; ++ks)
            sc[m] = mfma16(*reinterpret_cast<const bf16x8*>(Kl + (16 * m + fr) * 128 + (((4 * ks + fq) ^ (fr & 7)) << 4)), qfr[ks], sc[m]);
        }
        if (jb == qt) {
          const int lim = 8 * w2 + qbase + slot;
#pragma unroll
          for (int m = 0; m < 4; ++m)
#pragma unroll
            for (int j = 0; j < 4; ++j) if (16 * m + 4 * fq + j > lim) sc[m][j] = -INFINITY;
        }
        float bm = -1e30f;
#pragma unroll
        for (int m = 0; m < 4; ++m)
#pragma unroll
          for (int j = 0; j < 4; ++j) bm = fmaxf(bm, sc[m][j]);
        bm = fmax_x32(fmax_x16(bm));
        const float mn = fmaxf(mrun, bm), al = __builtin_amdgcn_exp2f(mrun - mn);
        float sum = 0.f;
#pragma unroll
        for (int m = 0; m < 4; ++m)
#pragma unroll
          for (int j = 0; j < 4; ++j) { const float e = __builtin_amdgcn_exp2f(sc[m][j] - mn); sc[m][j] = e; sum += e; }
        mrun = mn; lrun = lrun * al + sum;
#pragma unroll
        for (int dt = 0; dt < 4; ++dt) os[dt] *= al;
#pragma unroll
        for (int u2 = 0; u2 < 2; ++u2) {
          const bf16x8 pb = pack8(sc[2 * u2][0], sc[2 * u2][1], sc[2 * u2][2], sc[2 * u2][3], sc[2 * u2 + 1][0], sc[2 * u2 + 1][1], sc[2 * u2 + 1][2], sc[2 * u2 + 1][3]);
#pragma unroll
          for (int dt = 0; dt < 4; ++dt)
            os[dt] = mfma16(*reinterpret_cast<const bf16x8*>(Vl + (16 * dt + fr) * 128 + (((4 * u2 + fq) ^ (fr & 7)) << 4)), pb, os[dt]);
        }
      };
      auto proc_blk = [&](int c, int s2) {
        if (4 * c + s2 < nU) {
          const int jb = __builtin_amdgcn_readfirstlane((int)ulist[4 * c + s2]);
          const int mk = __builtin_amdgcn_readfirstlane((int)msk2[jb]);
          const char* Kl = smem + ATT_RING + ((c & 1) * 4 + s2) * 16384;
          if (mk & 15) step(osA, mA, lA, qA, 0, Kl, Kl + 8192, jb, mk & 15);
          if (mk >> 4) step(osB, mB, lB, qB, 4, Kl, Kl + 8192, jb, mk >> 4);
        }
      };
#pragma unroll 1
      for (int rep = 0; rep < ATT_REP_SLC; ++rep) {
        if (rep > 0) {
          __syncthreads();
#pragma unroll
          for (int dt = 0; dt < 4; ++dt) { osA[dt] = f32x4{0.f, 0.f, 0.f, 0.f}; osB[dt] = f32x4{0.f, 0.f, 0.f, 0.f}; }
          mA = -1e30f; lA = 0.f; mB = -1e30f; lB = 0.f;
        }
        SLC_GLOAD(0, 0); SLC_LSTORE(0, 0); SLC_GLOAD(0, 1); SLC_LSTORE(0, 1);
        __syncthreads();
#pragma unroll 1
        for (int c = 0; c < nchunk; ++c) {
          SLC_GLOAD(c + 1, 0);
          proc_blk(c, 0); proc_blk(c, 1);
          SLC_LSTORE(c + 1, 0);
          SLC_GLOAD(c + 1, 1);
          proc_blk(c, 2); proc_blk(c, 3);
          SLC_LSTORE(c + 1, 1);
          __syncthreads();
        }
      }
      {
        float* exch = reinterpret_cast<float*>(smem + ATT_RING) + w2 * 2048;
        const float ltA = fsum_x32(fsum_x16(lA)), ltB = fsum_x32(fsum_x16(lB));
        const size_t tokA = (size_t)b * S_ + q0 + 8 * w2 + slot;
        const float sA = NG[tokA * 24 + (hkv * 4 + gg) * 3 + 1] / ltA, sB = NG[(tokA + 4) * 24 + (hkv * 4 + gg) * 3 + 1] / ltB;
#pragma unroll
        for (int dt = 0; dt < 4; ++dt) {
          *reinterpret_cast<f32x4*>(exch + (slot * 4 + gg) * 64 + 16 * dt + 4 * fq) = osA[dt] * sA;
          *reinterpret_cast<f32x4*>(exch + ((slot + 4) * 4 + gg) * 64 + 16 * dt + 4 * fq) = osB[dt] * sB;
        }
        __builtin_amdgcn_wave_barrier();
        const int row = (tid2 & 31), h2 = (tid2 >> 5) & 1;
#pragma unroll
        for (int dt = 0; dt < 2; ++dt)
#pragma unroll
          for (int a = 0; a < 4; ++a) {
            const f32x4 v = *reinterpret_cast<const f32x4*>(exch + row * 64 + 32 * dt + 8 * a + 4 * h2);
            fin[dt][4 * a] += v[0]; fin[dt][4 * a + 1] += v[1]; fin[dt][4 * a + 2] += v[2]; fin[dt][4 * a + 3] += v[3];
          }
      }
    }
    {
      const int tid3 = tid_opaque(), r3 = tid3 & 31, h3 = (tid3 >> 5) & 1, w3 = tid3 >> 6;
      const size_t tok3 = (size_t)b * S_ + q0 + 8 * w3 + (r3 >> 2);
      const int head3 = hkv * 4 + (r3 & 3);
#pragma unroll
      for (int dt = 0; dt < 2; ++dt)
#pragma unroll
        for (int a = 0; a < 4; ++a)
          *reinterpret_cast<uint2*>(O + blk_off((int)tok3, 512, head3) + 32 * dt + 8 * a + 4 * h3) =
              make_uint2(pk2(fin[dt][4 * a], fin[dt][4 * a + 1]), pk2(fin[dt][4 * a + 2], fin[dt][4 * a + 3]));
    }
  }
}
DI void phg_gates(const P& p, int l, int half, char* smem) {
  char* ws = p.ws;
  const u16* XB = (const u16*)(ws + OFF_XB);
  const u16* Wt = (const u16*)(ws + OFF_W + l * WL_SIZE + WL_WGT);
  uint2* GF = (uint2*)(ws + RB_GF);
  for (int u = blockIdx.x; u < tile_slots(64 * 12); u += gridDim.x) {
    int rtl, cg; if (!tile_map(u, 64, 12, rtl, cg)) continue;
    const int brow = (half * 64 + rtl) * 256;
    int a0, a1, a2, a3; plain_rows(brow, a0, a1, a2, a3);
    f32x4 acc[2][2][4][2];
    gemm256<true, true>(XB, 1024, a0, a1, a2, a3, Wt, 1024, cg * 256, 16, (u16*)smem, acc);
    EPI_COORDS
    uint2* gt = GF + (size_t)(rtl * 12 + cg) * (32 * 512);
    EPI_LOOP {
      const int idx = ((ai * 2 + bj) * 4 + m) * 2 + n;
      const f32x4 v = acc[ai][bj][m][n];
      gt[idx * 512 + e_tz] = make_uint2(pk2(fsigmoid(v[0]), fsigmoid(v[1])), pk2(fsigmoid(v[2]), fsigmoid(v[3])));
    }
  }
}

DI void ph4_merge(const P& p, int l, int half, char* smem) {
  char* ws = p.ws;
  const char* wl = ws + OFF_W + l * WL_SIZE;
  u16* MRG = (u16*)(ws + RB_MRG);
  uint2* GF = (uint2*)(ws + RB_GF);
  for (int u = blockIdx.x; u < tile_slots(64 * 4); u += gridDim.x) {
    int rtl, ct; if (!tile_map(u, 64, 4, rtl, ct)) continue;
    const int brow = (half * 64 + rtl) * 256;
    uint2* run = GF + (size_t)(rtl * 12 + ct) * (32 * 512);
#pragma unroll 1
    for (int br = 0; br < 3; ++br) {
      f32x4 acc[2][2][4][2];
      int a0, a1, a2, a3; plain_rows(brow, a0, a1, a2, a3);
      const u16* Ab = (const u16*)(ws + (br == 0 ? RB_DB : br == 1 ? RB_YB : RB_O));
      const u16* Wb = (const u16*)(wl + (br == 0 ? WL_WEFF : br == 1 ? WL_WSG : WL_WNSA));
      gemm256<true, true>(Ab, 512, a0, a1, a2, a3, Wb, 512, ct * 256, 8, (u16*)smem, acc);
      EPI_COORDS
      const uint2* gt = GF + (size_t)(rtl * 12 + br * 4 + ct) * (32 * 512);
#pragma unroll
      for (int ai = 0; ai < 2; ++ai)
#pragma unroll
        for (int bj = 0; bj < 2; ++bj)
#pragma unroll
          for (int mh = 0; mh < 2; ++mh) {
            uint2 gg[2][2], pm[2][2];
#pragma unroll
            for (int mm = 0; mm < 2; ++mm)
#pragma unroll
              for (int n = 0; n < 2; ++n) {
                const int idx = ((ai * 2 + bj) * 4 + mh * 2 + mm) * 2 + n;
                gg[mm][n] = gt[idx * 512 + e_tz];
                pm[mm][n] = br > 0 ? run[idx * 512 + e_tz] : make_uint2(0u, 0u);
              }
#pragma unroll
            for (int mm = 0; mm < 2; ++mm)
#pragma unroll
              for (int n = 0; n < 2; ++n) {
                const int m = mh * 2 + mm;
                const int idx = ((ai * 2 + bj) * 4 + m) * 2 + n;
                f32x4 v = acc[ai][bj][m][n];
                v[0] = v[0] * bflo(gg[mm][n].x) + bflo(pm[mm][n].x); v[1] = v[1] * bfhi(gg[mm][n].x) + bfhi(pm[mm][n].x);
                v[2] = v[2] * bflo(gg[mm][n].y) + bflo(pm[mm][n].y); v[3] = v[3] * bfhi(gg[mm][n].y) + bfhi(pm[mm][n].y);
                if (br < 2) {
                  run[idx * 512 + e_tz] = make_uint2(pk2(v[0], v[1]), pk2(v[2], v[3]));
                } else {
                  const int col = ct * 256 + bj * 128 + wc * 32 + n * 16 + fr;
#pragma unroll
                  for (int j = 0; j < 4; ++j) MRG[(size_t)(brow + ai * 128 + wr * 64 + m * 16 + fq * 4 + j) * 1024 + col] = f2bf(v[j]);
                }
              }
          }
    }
  }
}

DI void ph5_out(const P& p, int l, char* smem) {
  char* ws = p.ws;
  const u16* MRG = (const u16*)(ws + RB_MRG);
  const u16* Wt = (const u16*)(ws + OFF_W + l * WL_SIZE + WL_WOUT);
  const float* xin = l == 0 ? p.x : p.out;
  for (int u = blockIdx.x; u < tile_slots(512); u += gridDim.x) {
    int rt, ct; if (!tile_map(u, 128, 4, rt, ct)) continue;
    const int brow = rt * 256;
    int a0, a1, a2, a3; plain_rows(brow, a0, a1, a2, a3);
    f32x4 acc[2][2][4][2];
    gemm256<false, true>(MRG, 1024, a0, a1, a2, a3, Wt, 1024, ct * 256, 16, (u16*)smem, acc);
    EPI_COORDS
#pragma unroll
    for (int ai = 0; ai < 2; ++ai)
#pragma unroll
      for (int bj = 0; bj < 2; ++bj) {
        const size_t base = (size_t)(brow + ai * 128 + wr * 64 + fq * 4) * 1024 + ct * 256 + bj * 128 + wc * 32 + fr;
        float old[4][2][4];
#pragma unroll
        for (int m = 0; m < 4; ++m)
#pragma unroll
          for (int n = 0; n < 2; ++n)
#pragma unroll
            for (int j = 0; j < 4; ++j) old[m][n][j] = xin[base + (size_t)(m * 16 + j) * 1024 + n * 16];
#pragma unroll
        for (int m = 0; m < 4; ++m)
#pragma unroll
          for (int n = 0; n < 2; ++n)
#pragma unroll
            for (int j = 0; j < 4; ++j) p.out[base + (size_t)(m * 16 + j) * 1024 + n * 16] = ALPHA_ * old[m][n][j] + acc[ai][bj][m][n][j];
      }
  }
}

template <int WHICH, bool MOE>
DI void ph_ln(const P& p, int l, char* smem) {
  char* ws = p.ws;
  const int tid = tid_opaque(), w = tid >> 6, lane = tid & 63;
  const float* gam = (WHICH == 1 ? p.ln1_g : p.ln2_g) + (size_t)l * 1024;
  const float* bet = (WHICH == 1 ? p.ln1_b : p.ln2_b) + (size_t)l * 1024;
  u16* XB = (u16*)(ws + OFF_XB);
  int* lcnt = reinterpret_cast<int*>(smem);
  float* srw = reinterpret_cast<float*>(smem + 1024);
  if (MOE) { for (int i = tid; i < 8192 / 4; i += NTHR) reinterpret_cast<float4*>(srw)[i] = reinterpret_cast<const float4*>(p.moe_r)[i]; __syncthreads(); }
  int* TOKE = (int*)(ws + OFF_TOKE); float* TOKW = (float*)(ws + OFF_TOKW);
  unsigned* gcnt = (unsigned*)(ws + OFF_CNT);
  float4 gv[4], bv[4];
#pragma unroll
  for (int i = 0; i < 4; ++i) { gv[i] = *reinterpret_cast<const float4*>(gam + (i * 64 + lane) * 4); bv[i] = *reinterpret_cast<const float4*>(bet + (i * 64 + lane) * 4); }
  for (int rb = blockIdx.x; rb < 256; rb += gridDim.x) {
    if (MOE) { __syncthreads(); if (tid < 24) lcnt[tid] = 0; __syncthreads(); }
    float4 vn[4], vm[4];
    float4 pn = make_float4(0.f, 0.f, 0.f, 0.f), pm = pn;
#pragma unroll
    for (int i = 0; i < 4; ++i) {
      vn[i] = *reinterpret_cast<const float4*>(p.out + (size_t)(rb * 128 + w * 16) * 1024 + (i * 64 + lane) * 4);
      vm[i] = *reinterpret_cast<const float4*>(p.out + (size_t)(rb * 128 + w * 16 + 1) * 1024 + (i * 64 + lane) * 4);
    }
    if (WHICH == 1) {
      pn = *reinterpret_cast<const float4*>(p.p + ((size_t)l * T_ + rb * 128 + w * 16) * 256 + lane * 4);
      pm = *reinterpret_cast<const float4*>(p.p + ((size_t)l * T_ + rb * 128 + w * 16 + 1) * 256 + lane * 4);
    }
#pragma unroll 1
    for (int ri = 0; ri < 16; ++ri) {
      const int row = rb * 128 + w * 16 + ri;
      float* xr = p.out + (size_t)row * 1024;
      float4 v[4];
#pragma unroll
      for (int i = 0; i < 4; ++i) { v[i] = vn[i]; vn[i] = vm[i]; }
      const float4 pv = pn; pn = pm;
      {
        const int rn = ri < 14 ? row + 2 : row;
#pragma unroll
        for (int i = 0; i < 4; ++i) vm[i] = *reinterpret_cast<const float4*>(p.out + (size_t)rn * 1024 + (i * 64 + lane) * 4);
        if (WHICH == 1) pm = *reinterpret_cast<const float4*>(p.p + ((size_t)l * T_ + rn) * 256 + lane * 4);
      }
      float s = 0.f;
#pragma unroll
      for (int i = 0; i < 4; ++i) s += v[i].x + v[i].y + v[i].z + v[i].w;
      const float mu = wave_sum(s) * (1.f / 1024.f);
      float q = 0.f;
#pragma unroll
      for (int i = 0; i < 4; ++i) { v[i].x -= mu; v[i].y -= mu; v[i].z -= mu; v[i].w -= mu; q += v[i].x * v[i].x + v[i].y * v[i].y + v[i].z * v[i].z + v[i].w * v[i].w; }
      const float rs = rsqrtf(wave_sum(q) * (1.f / 1024.f) + 1e-5f);
#pragma unroll
      for (int i = 0; i < 4; ++i) {
        v[i].x = v[i].x * rs * gv[i].x + bv[i].x; v[i].y = v[i].y * rs * gv[i].y + bv[i].y;
        v[i].z = v[i].z * rs * gv[i].z + bv[i].z; v[i].w = v[i].w * rs * gv[i].w + bv[i].w;
        const float sc = WHICH == 1 ? ALPHA_ : 1.f;
        *reinterpret_cast<float4*>(xr + (i * 64 + lane) * 4) = make_float4(sc * v[i].x, sc * v[i].y, sc * v[i].z, sc * v[i].w);
        *reinterpret_cast<uint2*>(XB + blk_off(row, 1024, (i * 64 + lane) >> 4) + (((i * 64 + lane) * 4) & 63)) = make_uint2(pk2(v[i].x, v[i].y), pk2(v[i].z, v[i].w));
      }
      if (WHICH == 1) {
        *reinterpret_cast<uint2*>((u16*)(ws + RB_PB) + (size_t)row * 256 + lane * 4) = make_uint2(pk2(pv.x, pv.y), pk2(pv.z, pv.w));
      }
      if (MOE) {
        const float* wr_ = srw;
        float lg[8];
#pragma unroll
        for (int e = 0; e < 8; ++e) lg[e] = 0.f;
#pragma unroll
        for (int i = 0; i < 4; ++i) {
          const float xs[4] = {v[i].x, v[i].y, v[i].z, v[i].w};
#pragma unroll
          for (int k = 0; k < 4; ++k) {
            const float4 wa = *reinterpret_cast<const float4*>(wr_ + (size_t)((i * 64 + lane) * 4 + k) * 8);
            const float4 wb = *reinterpret_cast<const float4*>(wr_ + (size_t)((i * 64 + lane) * 4 + k) * 8 + 4);
            lg[0] += xs[k] * wa.x; lg[1] += xs[k] * wa.y; lg[2] += xs[k] * wa.z; lg[3] += xs[k] * wa.w;
            lg[4] += xs[k] * wb.x; lg[5] += xs[k] * wb.y; lg[6] += xs[k] * wb.z; lg[7] += xs[k] * wb.w;
          }
        }
#pragma unroll
        for (int e = 0; e < 8; ++e) lg[e] = wave_sum(lg[e]) + p.moe_rb[e];
        if (lane == 0) {
          int e0 = 0; float b0 = lg[0];
#pragma unroll
          for (int e = 1; e < 8; ++e) if (lg[e] > b0) { b0 = lg[e]; e0 = e; }
          int e1 = -1; float b1 = -3.0e38f;
#pragma unroll
          for (int e = 0; e < 8; ++e) if (e != e0 && lg[e] > b1) { b1 = lg[e]; e1 = e; }
          const float ex = __expf(b1 - b0), w0 = 1.f / (1.f + ex), w1 = ex * w0;
          TOKE[row * 2] = e0; TOKE[row * 2 + 1] = e1; TOKW[row * 2] = w0; TOKW[row * 2 + 1] = w1;
          atomicAdd(&lcnt[e0], 1); atomicAdd(&lcnt[e1], 1);
        }
      }
    }
    if (MOE) {
      int* ROWT = (int*)(ws + OFF_ROWT); float* ROWW = (float*)(ws + OFF_ROWW);
      __syncthreads();
      if (tid < 8) lcnt[8 + tid] = (int)atomicAdd(&gcnt[tid * 64], (unsigned)lcnt[tid]);
      __syncthreads();
      if (tid < 256) {
        const int tk = rb * 128 + (tid >> 1), sl = tid & 1;
        const int e = TOKE[tk * 2 + sl];
        const int pos = lcnt[8 + e] + atomicAdd(&lcnt[16 + e], 1);
        ROWT[e * 65536 + pos] = tk; ROWW[e * 65536 + pos] = TOKW[tk * 2 + sl];
      }
    }
  }
}

DI void ph_ple(const P& p, int l, char* smem) {
  char* ws = p.ws;
  const u16* XB = (const u16*)(ws + OFF_XB);
  const u16* PB = (const u16*)(ws + RB_PB);
  const char* wl = ws + OFF_W + l * WL_SIZE;
  const float* gb = p.ple_gb + (size_t)l * 1024;
  unsigned* scr = (unsigned*)(ws + RB_SCRP) + (size_t)blockIdx.x * (32 * 512 * 2);
  for (int u = blockIdx.x; u < tile_slots(512); u += gridDim.x) {
    int rt, ct; if (!tile_map(u, 128, 4, rt, ct)) continue;
    const int brow = rt * 256;
    int a0, a1, a2, a3; plain_rows(brow, a0, a1, a2, a3);
    f32x4 acc[2][2][4][2];
    gemm256<false, true>(PB, 256, a0, a1, a2, a3, (const u16*)(wl + WL_WPP), 256, ct * 256, 4, (u16*)smem, acc);
    {
      EPI_COORDS
      EPI_LOOP {
        const int idx = ((ai * 2 + bj) * 4 + m) * 2 + n;
        const f32x4 v = acc[ai][bj][m][n];
        *reinterpret_cast<uint2*>(scr + ((size_t)idx * 512 + e_tz) * 2) = make_uint2(pk2(v[0], v[1]), pk2(v[2], v[3]));
      }
    }
    plain_rows(brow, a0, a1, a2, a3);
    gemm256<true, true>(XB, 1024, a0, a1, a2, a3, (const u16*)(wl + WL_WPG), 1024, ct * 256, 16, (u16*)smem, acc);
    {
      EPI_COORDS
#pragma unroll
      for (int ai = 0; ai < 2; ++ai)
#pragma unroll
        for (int bj = 0; bj < 2; ++bj) {
          const size_t base = (size_t)(brow + ai * 128 + wr * 64 + fq * 4) * 1024 + ct * 256 + bj * 128 + wc * 32 + fr;
          float old[4][2][4];
#pragma unroll
          for (int m = 0; m < 4; ++m)
#pragma unroll
            for (int n = 0; n < 2; ++n)
#pragma unroll
              for (int j = 0; j < 4; ++j) old[m][n][j] = p.out[base + (size_t)(m * 16 + j) * 1024 + n * 16];
          uint2 ggq[4][2]; float bbq[2];
#pragma unroll
          for (int m = 0; m < 4; ++m)
#pragma unroll
            for (int n = 0; n < 2; ++n) ggq[m][n] = *reinterpret_cast<const uint2*>(scr + ((size_t)(((ai * 2 + bj) * 4 + m) * 2 + n) * 512 + e_tz) * 2);
#pragma unroll
          for (int n = 0; n < 2; ++n) bbq[n] = gb[ct * 256 + bj * 128 + wc * 32 + n * 16 + fr];
#pragma unroll
          for (int m = 0; m < 4; ++m)
#pragma unroll
            for (int n = 0; n < 2; ++n) {
              const uint2 gg = ggq[m][n];
              const float pp[4] = {bflo(gg.x), bfhi(gg.x), bflo(gg.y), bfhi(gg.y)};
              const float bb = bbq[n];
#pragma unroll
              for (int j = 0; j < 4; ++j)
                p.out[base + (size_t)(m * 16 + j) * 1024 + n * 16] = old[m][n][j] + fsigmoid(acc[ai][bj][m][n][j] + bb) * pp[j];
            }
        }
    }
  }
}

DI void ph_ffn_gu(const P& p, char* smem) {
  char* ws = p.ws;
  const u16* XB = (const u16*)(ws + OFF_XB);
  const u16* Wt = (const u16*)(ws + OFF_WFFN);
  u16* ACT = (u16*)(ws + RB_ACT);
  for (int u = blockIdx.x; u < tile_slots(128 * 22); u += gridDim.x) {
    int rt, ct; if (!tile_map(u, 128, 22, rt, ct)) continue;
    const int brow = rt * 256;
    int a0, a1, a2, a3; plain_rows(brow, a0, a1, a2, a3);
    f32x4 acc[2][2][4][2];
    gemm256<true, true>(XB, 1024, a0, a1, a2, a3, Wt, 1024, ct * 256, 16, (u16*)smem, acc);
    EPI_COORDS
#pragma unroll
    for (int ai = 0; ai < 2; ++ai)
#pragma unroll
      for (int m = 0; m < 4; ++m)
#pragma unroll
        for (int n = 0; n < 2; ++n)
#pragma unroll
          for (int j = 0; j < 4; ++j) {
            const int row = brow + ai * 128 + wr * 64 + m * 16 + fq * 4 + j;
            ACT[(size_t)row * DFF + ct * 128 + wc * 32 + n * 16 + fr] = f2bf(fsilu(acc[ai][0][m][n][j]) * acc[ai][1][m][n][j]);
          }
  }
}
DI void ph_ffn_dn(const P& p, char* smem) {
  char* ws = p.ws;
  const u16* ACT = (const u16*)(ws + RB_ACT);
  const u16* Wt = (const u16*)(ws + OFF_WFFN + (size_t)5632 * 1024 * 2);
  for (int u = blockIdx.x; u < tile_slots(512); u += gridDim.x) {
    int rt, ct; if (!tile_map(u, 128, 4, rt, ct)) continue;
    const int brow = rt * 256;
    int a0, a1, a2, a3; plain_rows(brow, a0, a1, a2, a3);
    f32x4 acc[2][2][4][2];
    gemm256<false, true>(ACT, DFF, a0, a1, a2, a3, Wt, DFF, ct * 256, 44, (u16*)smem, acc);
    EPI_COORDS
#pragma unroll
    for (int ai = 0; ai < 2; ++ai)
#pragma unroll
      for (int bj = 0; bj < 2; ++bj) {
        const size_t base = (size_t)(brow + ai * 128 + wr * 64 + fq * 4) * 1024 + ct * 256 + bj * 128 + wc * 32 + fr;
        float old[4][2][4];
#pragma unroll
        for (int m = 0; m < 4; ++m)
#pragma unroll
          for (int n = 0; n < 2; ++n)
#pragma unroll
            for (int j = 0; j < 4; ++j) old[m][n][j] = p.out[base + (size_t)(m * 16 + j) * 1024 + n * 16];
#pragma unroll
        for (int m = 0; m < 4; ++m)
#pragma unroll
          for (int n = 0; n < 2; ++n)
#pragma unroll
            for (int j = 0; j < 4; ++j) p.out[base + (size_t)(m * 16 + j) * 1024 + n * 16] = old[m][n][j] + acc[ai][bj][m][n][j];
      }
  }
}

struct MoeMap { int cnt[8]; int tstart[9]; };
DI void moe_map(const P& p, MoeMap& mm) {
  const unsigned* gcnt = (const unsigned*)(p.ws + OFF_CNT);
  int acc = 0;
#pragma unroll
  for (int e = 0; e < 8; ++e) { const int c = __builtin_amdgcn_readfirstlane((int)gcnt[e * 64]); mm.cnt[e] = c; mm.tstart[e] = acc; acc += ((c + 511) >> 9) * 2; }
  mm.tstart[8] = acc;
}
DI void moe_find(const MoeMap& mm, int gt, int& e, int& lt) {
  e = 0;
#pragma unroll
  for (int k = 1; k < 8; ++k) if (gt >= mm.tstart[k]) e = k;
  lt = 0;
#pragma unroll
  for (int k = 0; k < 8; ++k) if (k == e) lt = gt - mm.tstart[k];
}
DI int moe_cnt(const MoeMap& mm, int e) { int c = 0;
#pragma unroll
  for (int k = 0; k < 8; ++k) if (k == e) c = mm.cnt[k];
  return c; }

DI void ph_moe_gu(const P& p, int ch, char* smem) {
  char* ws = p.ws;
  MoeMap mm; moe_map(p, mm);
  const int t0 = ch * 128, t1 = min(mm.tstart[8], t0 + 128);
  const u16* XB = (const u16*)(ws + OFF_XB);
  const int* ROWT = (const int*)(ws + OFF_ROWT);
  u16* ACT = (u16*)(ws + RB_ACT);
  for (int u = blockIdx.x; u < tile_slots((t1 - t0) * 22); u += gridDim.x) {
    int rtl, ct; if (!tile_map(u, t1 - t0, 22, rtl, ct)) continue;
    const int gt = t0 + rtl;
    int e, lt; moe_find(mm, gt, e, lt);
    const int cnt = moe_cnt(mm, e);
    const u16* Wt = (const u16*)(ws + OFF_WMOE + (size_t)e * FFN_E_SIZE);
    int r0, c0; stage_rc(tid_opaque() * 16, r0, c0);
    int ar[4];
#pragma unroll
    for (int k = 0; k < 4; ++k) { const int lr = lt * 256 + r0 + 64 * k; ar[k] = lr < cnt ? ROWT[e * 65536 + lr] : 0; }
    f32x4 acc[2][2][4][2];
    gemm256<true, true, true>(XB, 1024, ar[0], ar[1], ar[2], ar[3], Wt, 1024, ct * 256, 16, (u16*)smem, acc);
    EPI_COORDS
    const int brow = (gt - t0) * 256;
#pragma unroll
    for (int ai = 0; ai < 2; ++ai)
#pragma unroll
      for (int m = 0; m < 4; ++m)
#pragma unroll
        for (int n = 0; n < 2; ++n)
#pragma unroll
          for (int j = 0; j < 4; ++j) {
            const int row = brow + ai * 128 + wr * 64 + m * 16 + fq * 4 + j;
            ACT[(size_t)row * DFF + ct * 128 + wc * 32 + n * 16 + fr] = f2bf(fsilu(acc[ai][0][m][n][j]) * acc[ai][1][m][n][j]);
          }
  }
}
DI void ph_moe_dn(const P& p, int ch, char* smem) {
  char* ws = p.ws;
  MoeMap mm; moe_map(p, mm);
  const int t0 = ch * 128, t1 = min(mm.tstart[8], t0 + 128);
  const u16* ACT = (const u16*)(ws + RB_ACT);
  const int* ROWT = (const int*)(ws + OFF_ROWT);
  const float* ROWW = (const float*)(ws + OFF_ROWW);
  const int ksp = ch == 2 ? 4 : 1;
  for (int u = blockIdx.x; u < tile_slots((t1 - t0) * 4 * ksp); u += gridDim.x) {
    int rtl, cc; if (!tile_map(u, t1 - t0, 4 * ksp, rtl, cc)) continue;
    const int ks = cc % ksp, ct = cc / ksp;
    const int gt = t0 + rtl;
    int e, lt; moe_find(mm, gt, e, lt);
    const int cnt = moe_cnt(mm, e);
    const u16* Wt = (const u16*)(ws + OFF_WMOE + (size_t)e * FFN_E_SIZE + (size_t)5632 * 1024 * 2);
    const int brow = (gt - t0) * 256;
    int a0, a1, a2, a3; plain_rows(brow, a0, a1, a2, a3);
    f32x4 acc[2][2][4][2];
    const int kt0 = ksp == 1 ? 0 : (ks == 0 ? 0 : ks == 1 ? 12 : ks == 2 ? 24 : 34);
    const int ktn = ksp == 1 ? 44 : (ks < 2 ? 12 : 10);
    gemm256<false, true>(ACT, DFF, a0, a1, a2, a3, Wt, DFF, ct * 256, ktn, (u16*)smem, acc, kt0);
    EPI_COORDS
#pragma unroll
    for (int ai = 0; ai < 2; ++ai) {
      int tkq[4][4]; float wtq[4][4];
#pragma unroll
      for (int m = 0; m < 4; ++m)
#pragma unroll
        for (int j = 0; j < 4; ++j) {
          const int lr = lt * 256 + ai * 128 + wr * 64 + m * 16 + fq * 4 + j;
          const bool ok = lr < cnt;
          tkq[m][j] = ok ? ROWT[e * 65536 + lr] : -1;
          wtq[m][j] = ok ? ROWW[e * 65536 + lr] : 0.f;
        }
#pragma unroll
      for (int m = 0; m < 4; ++m)
#pragma unroll
        for (int j = 0; j < 4; ++j) {
          const int tk = tkq[m][j];
          if (tk >= 0) {
            const float wt = wtq[m][j];
#pragma unroll
            for (int bj = 0; bj < 2; ++bj)
#pragma unroll
              for (int n = 0; n < 2; ++n)
                unsafeAtomicAdd(&p.out[(size_t)tk * 1024 + ct * 256 + bj * 128 + wc * 32 + n * 16 + fr], wt * acc[ai][bj][m][n][j]);
          }
        }
    }
  }
}
constexpr int NPH = 33;
template <int ID> DI void run_phase(const P& p, char* smem) {
  if constexpr (ID == 0) prologue_phase(p, smem);
  else if constexpr (ID == 1)  ph1_proj(p, 0, smem);
  else if constexpr (ID == 2)  ph2_mix(p, 0, smem);
  else if constexpr (ID == 3)  ph2b_cmp2(p, 0, smem);
  else if constexpr (ID == 4)  ph3_attn(p, 0, smem);
  else if constexpr (ID == 5)  phg_gates(p, 0, 0, smem);
  else if constexpr (ID == 6)  ph4_merge(p, 0, 0, smem);
  else if constexpr (ID == 7)  phg_gates(p, 0, 1, smem);
  else if constexpr (ID == 8)  ph4_merge(p, 0, 1, smem);
  else if constexpr (ID == 9)  ph5_out(p, 0, smem);
  else if constexpr (ID == 10) ph_ln<1, false>(p, 0, smem);
  else if constexpr (ID == 11) ph_ple(p, 0, smem);
  else if constexpr (ID == 12) ph_ffn_gu(p, smem);
  else if constexpr (ID == 13) ph_ffn_dn(p, smem);
  else if constexpr (ID == 14) ph_ln<2, false>(p, 0, smem);
  else if constexpr (ID == 15) ph1_proj(p, 1, smem);
  else if constexpr (ID == 16) ph2_mix(p, 1, smem);
  else if constexpr (ID == 17) ph2b_cmp2(p, 1, smem);
  else if constexpr (ID == 18) ph3_attn(p, 1, smem);
  else if constexpr (ID == 19) phg_gates(p, 1, 0, smem);
  else if constexpr (ID == 20) ph4_merge(p, 1, 0, smem);
  else if constexpr (ID == 21) phg_gates(p, 1, 1, smem);
  else if constexpr (ID == 22) ph4_merge(p, 1, 1, smem);
  else if constexpr (ID == 23) ph5_out(p, 1, smem);
  else if constexpr (ID == 24) ph_ln<1, true>(p, 1, smem);
  else if constexpr (ID == 25) ph_ple(p, 1, smem);
  else if constexpr (ID == 26) ph_moe_gu(p, 0, smem);
  else if constexpr (ID == 27) ph_moe_dn(p, 0, smem);
  else if constexpr (ID == 28) ph_moe_gu(p, 1, smem);
  else if constexpr (ID == 29) ph_moe_dn(p, 1, smem);
  else if constexpr (ID == 30) ph_moe_gu(p, 2, smem);
  else if constexpr (ID == 31) ph_moe_dn(p, 2, smem);
  else if constexpr (ID == 32) ph_ln<2, false>(p, 1, smem);
}

#ifndef MK_MULTI
#define MK_MULTI 0
#endif

#if MK_MULTI
template <int ID> __global__ void __launch_bounds__(NTHR, 2) k_one(P p) {
  extern __shared__ __attribute__((aligned(16))) char smem[];
  run_phase<ID>(p, smem);
}
typedef void (*kfn_t)(P);
template <int... I> static void launch_all(std::integer_sequence<int, I...>, const P& prm, hipStream_t stream, bool init) {
  kfn_t fns[] = { k_one<I>... };
  for (int i = 0; i < (int)sizeof...(I); ++i) {
    if (init) hipFuncSetAttribute((const void*)fns[i], hipFuncAttributeMaxDynamicSharedMemorySize, LDS_BYTES);
    else hipLaunchKernelGGL(fns[i], dim3(256), dim3(NTHR), LDS_BYTES, stream, prm);
  }
}
#else
constexpr unsigned long long DUPMASK = 0ull;
template <int ID> DI void run_from(const P& p, char* smem, const XcdBarrier& bar) {
  run_phase<ID>(p, smem);
  if constexpr ((DUPMASK >> ID) & 1ull) { xcd_barrier(bar); run_phase<ID>(p, smem); }
  if constexpr (ID + 1 < NPH) { xcd_barrier(bar); run_from<ID + 1>(p, smem, bar); }
}
__global__ void __launch_bounds__(NTHR, 2) k_mega(P p) {
  extern __shared__ __attribute__((aligned(16))) char smem[];
  uint4* xbw = reinterpret_cast<uint4*>(smem + 147456);
  if (threadIdx.x == 0) *xbw = make_uint4(0u, 0u, 0u, 0u);
  __syncthreads();
  XcdBarrier bar = xcd_barrier_post((unsigned*)(p.ws + OFF_BAR), (volatile LAS unsigned*)xbw);
  run_from<0>(p, smem, bar);
}
#endif

extern "C" void kernel_launch(void* const* d_in, const int* in_sizes, int n_in, void* d_out, int out_size, void* d_ws, size_t ws_size, hipStream_t stream) {
  (void)in_sizes; (void)n_in; (void)out_size;
  static_assert(sizeof(P) == 37 * sizeof(void*), "P must be 37 pointers");
  P prm{};
  const void* arr[37];
  for (int i = 0; i < 35; ++i) arr[i] = d_in[i];
  arr[35] = d_out; arr[36] = d_ws;
  memcpy(&prm, arr, sizeof(prm));
  if (ws_size < WS_NEED) { fprintf(stderr, "workspace too small: %zu < %zu\n", ws_size, (size_t)WS_NEED); }
  hipMemsetAsync(d_ws, 0, ZERO_BYTES, stream);
#if MK_MULTI
  static bool inited = false;
  if (!inited) { launch_all(std::make_integer_sequence<int, NPH>{}, prm, stream, true); inited = true; }
  launch_all(std::make_integer_sequence<int, NPH>{}, prm, stream, false);
#else
  static int grid = 0;
  if (!grid) {
    hipFuncSetAttribute((const void*)k_mega, hipFuncAttributeMaxDynamicSharedMemorySize, LDS_BYTES);
    int dev = 0, cus = 0, per_cu = 0;
    hipGetDevice(&dev);
    hipDeviceGetAttribute(&cus, hipDeviceAttributeMultiprocessorCount, dev);
    hipOccupancyMaxActiveBlocksPerMultiprocessor(&per_cu, k_mega, NTHR, LDS_BYTES);
    grid = cus * (per_cu < 1 ? per_cu : 1);
    if (grid <= 0 || grid > 256) grid = 256;
  }
  hipLaunchKernelGGL(k_mega, dim3(grid), dim3(NTHR), LDS_BYTES, stream, prm);
#endif
}
```

```cpp
#include <hip/hip_runtime.h>
#include <stdint.h>
#include <stdio.h>
#include <string.h>

#define DI __device__ __forceinline__
typedef unsigned short u16;
using bf16x8 = __attribute__((ext_vector_type(8))) short;
using f32x4  = __attribute__((ext_vector_type(4))) float;
using f32x16 = __attribute__((ext_vector_type(16))) float;
using u32x4  = __attribute__((ext_vector_type(4))) unsigned;
using u32x2  = __attribute__((ext_vector_type(2))) unsigned;
typedef __bf16 bf2_t __attribute__((ext_vector_type(2)));
typedef float  f2_t  __attribute__((ext_vector_type(2)));

constexpr int T_ = 32768, S_ = 16384, D_ = 1024, NB_ = 2;
constexpr int INW = 5912, DFF = 2816, NEXP = 8;
constexpr float ALPHA_ = 1.41421356237309515f;
constexpr int NTHR = 512;
constexpr int LDS_BYTES = 148480;

DI int tid_opaque() { int t = threadIdx.x; asm volatile("" : "+v"(t)); return t; }
DI unsigned pk2(float a, float b) { f2_t v = {a, b}; bf2_t r = __builtin_convertvector(v, bf2_t); return __builtin_bit_cast(unsigned, r); }
DI u16 f2bf(float a) { return (u16)(pk2(a, 0.f) & 0xffffu); }
DI float bf2f(u16 h) { return __uint_as_float(((unsigned)h) << 16); }
DI float bflo(unsigned u) { return __uint_as_float(u << 16); }
DI float bfhi(unsigned u) { return __uint_as_float(u & 0xffff0000u); }
DI float fsigmoid(float x) { return __builtin_amdgcn_rcpf(1.f + __expf(-x)); }
DI float fgelu(float x) { float y = 0.7978845608028654f * (x + 0.044715f * x * x * x); return x * fsigmoid(2.f * y); }
DI float fsilu(float x) { return x * fsigmoid(x); }

typedef unsigned u2v_t __attribute__((ext_vector_type(2)));
template <int CTRL> DI unsigned dpp_mov(unsigned x) { return (unsigned)__builtin_amdgcn_update_dpp(0, (int)x, CTRL, 0xF, 0xF, true); }
DI float fmax_x16(float x) { const unsigned u = __float_as_uint(x); const u2v_t r = __builtin_amdgcn_permlane16_swap(u, u, false, false); return fmaxf(__uint_as_float(r[0]), __uint_as_float(r[1])); }
DI float fmax_x32(float x) { const unsigned u = __float_as_uint(x); const u2v_t r = __builtin_amdgcn_permlane32_swap(u, u, false, false); return fmaxf(__uint_as_float(r[0]), __uint_as_float(r[1])); }
DI float fsum_x16(float x) { const unsigned u = __float_as_uint(x); const u2v_t r = __builtin_amdgcn_permlane16_swap(u, u, false, false); return __uint_as_float(r[0]) + __uint_as_float(r[1]); }
DI float fsum_x32(float x) { const unsigned u = __float_as_uint(x); const u2v_t r = __builtin_amdgcn_permlane32_swap(u, u, false, false); return __uint_as_float(r[0]) + __uint_as_float(r[1]); }
DI unsigned long long umax64(unsigned long long a, unsigned long long b) { return a > b ? a : b; }
DI unsigned long long wave_max_u64(unsigned long long v) {
  unsigned lo = (unsigned)v, hi = (unsigned)(v >> 32);
#define WM_STEP(CTRL) { const unsigned lo2 = dpp_mov<CTRL>(lo), hi2 = dpp_mov<CTRL>(hi); const unsigned long long o = ((unsigned long long)hi2 << 32) | lo2, c = ((unsigned long long)hi << 32) | lo; \
    const unsigned long long m_ = umax64(o, c); lo = (unsigned)m_; hi = (unsigned)(m_ >> 32); }
  WM_STEP(0xB1) WM_STEP(0x4E) WM_STEP(0x141) WM_STEP(0x140)
#undef WM_STEP
  { const u2v_t rl = __builtin_amdgcn_permlane16_swap(lo, lo, false, false), rh = __builtin_amdgcn_permlane16_swap(hi, hi, false, false);
    const unsigned long long m_ = umax64(((unsigned long long)rh[0] << 32) | rl[0], ((unsigned long long)rh[1] << 32) | rl[1]); lo = (unsigned)m_; hi = (unsigned)(m_ >> 32); }
  { const u2v_t rl = __builtin_amdgcn_permlane32_swap(lo, lo, false, false), rh = __builtin_amdgcn_permlane32_swap(hi, hi, false, false);
    const unsigned long long m_ = umax64(((unsigned long long)rh[0] << 32) | rl[0], ((unsigned long long)rh[1] << 32) | rl[1]); lo = (unsigned)m_; hi = (unsigned)(m_ >> 32); }
  return ((unsigned long long)hi << 32) | lo;
}
DI float wave_sum(float v) {
  v += __uint_as_float(dpp_mov<0xB1>(__float_as_uint(v)));
  v += __uint_as_float(dpp_mov<0x4E>(__float_as_uint(v)));
  v += __uint_as_float(dpp_mov<0x141>(__float_as_uint(v)));
  v += __uint_as_float(dpp_mov<0x140>(__float_as_uint(v)));
  return fsum_x32(fsum_x16(v));
}
struct P {
  const float *x, *p; const int* pos;
  const float *w_in, *pool_w, *pool_scale, *sg_ln_g, *sg_ln_b, *sg_w, *sg_b;
  const float *ck_pos, *ck_w1, *ck_w2, *cv_pos, *cv_w1, *cv_w2;
  const float *w_pool_out, *w_sg_out, *w_nsa_out, *w_out, *ln1_g, *ln1_b;
  const float *ffn_g, *ffn_u, *ffn_d, *moe_r, *moe_rb, *moe_g, *moe_u, *moe_d;
  const float *ple_gw, *ple_gb, *ple_pj, *ln2_g, *ln2_b;
  float* out; char* ws;
};

constexpr size_t MB = 1048576;
constexpr size_t OFF_BAR   = 0;
constexpr size_t OFF_CNT   = 16384;
constexpr size_t ZERO_BYTES = 32768;
constexpr size_t OFF_ROPE  = 65536;
constexpr size_t OFF_NG    = OFF_ROPE + 2 * MB;
constexpr size_t OFF_KCMP  = OFF_NG + 3 * MB;
constexpr size_t OFF_VCMPT = OFF_KCMP + MB / 2;
constexpr size_t OFF_POSB  = OFF_VCMPT + MB / 2;
constexpr size_t OFF_AH    = OFF_POSB + 65536;
constexpr size_t OFF_TOKE  = OFF_AH + 4 * MB;
constexpr size_t OFF_TOKW  = OFF_TOKE + MB / 4;
constexpr size_t OFF_ROWT  = OFF_TOKW + MB / 4;
constexpr size_t OFF_ROWW  = OFF_ROWT + 2 * MB;
constexpr size_t OFF_W     = 16 * MB;
constexpr size_t WL_WINT = 0;
constexpr size_t WL_WGT  = WL_WINT + (size_t)3072 * 1024 * 2;
constexpr size_t WL_WEFF = WL_WGT  + (size_t)3072 * 1024 * 2;
constexpr size_t WL_WSG  = WL_WEFF + (size_t)1024 * 512 * 2;
constexpr size_t WL_WNSA = WL_WSG  + (size_t)1024 * 512 * 2;
constexpr size_t WL_WOUT = WL_WNSA + (size_t)1024 * 512 * 2;
constexpr size_t WL_WPG  = WL_WOUT + (size_t)1024 * 1024 * 2;
constexpr size_t WL_WPP  = WL_WPG  + (size_t)1024 * 1024 * 2;
constexpr size_t WL_W1K  = WL_WPP  + (size_t)1024 * 256 * 2;
constexpr size_t WL_W1V  = WL_W1K  + (size_t)256 * 2048 * 2;
constexpr size_t WL_SGW  = WL_W1V  + (size_t)256 * 2048 * 2;
constexpr size_t WL_SIZE = WL_SGW  + (size_t)4 * 128 * 128 * 2;
constexpr size_t OFF_WFFN = OFF_W + 2 * WL_SIZE;
constexpr size_t FFN_E_SIZE = (size_t)5632 * 1024 * 2 + (size_t)1024 * 2816 * 2;
constexpr size_t OFF_WMOE = OFF_WFFN + FFN_E_SIZE;
constexpr size_t OFF_XB   = OFF_WMOE + 8 * FFN_E_SIZE;
constexpr size_t OFF_RB   = OFF_XB + (size_t)T_ * 1024 * 2;
constexpr size_t TB512 = (size_t)T_ * 512 * 2;
constexpr size_t KVB   = (size_t)4 * S_ * 64 * 2;
constexpr size_t RB_A   = OFF_RB;
constexpr size_t RB_GU  = RB_A + TB512;
constexpr size_t RB_GV  = RB_GU + TB512;
constexpr size_t RB_Q   = RB_GV + TB512;
constexpr size_t RB_KC  = RB_Q + TB512;
constexpr size_t RB_VC  = RB_KC + KVB;
constexpr size_t RB_KS  = RB_VC + KVB;
constexpr size_t RB_VST = RB_KS + KVB;
constexpr size_t RB_KW  = RB_VST + KVB;
constexpr size_t RB_VWT = RB_KW + KVB;
constexpr size_t RB_HID = RB_VWT + KVB + MB;
constexpr size_t RB_DB   = RB_HID + 16 * MB;
constexpr size_t RB_YB   = RB_DB + TB512;
constexpr size_t RB_O    = RB_YB + TB512;
constexpr size_t RB_GF   = OFF_RB;
constexpr size_t RB_MRG  = RB_Q;
constexpr size_t RB_SCR4 = RB_YB + TB512;
constexpr size_t RB_SCM4 = OFF_RB;
constexpr size_t RB_G    = OFF_RB + 96 * MB;
constexpr size_t RB_PB   = OFF_RB;
constexpr size_t RB_SCRP = OFF_RB + 16 * MB;
constexpr size_t RB_ACT  = OFF_RB;
constexpr size_t RB_SIZE = 290 * MB;
constexpr size_t WS_NEED = OFF_RB + RB_SIZE;

#define XB_TMO      128
#define XB_XCNT(j)  (256  + 64 * (j))
#define XB_XSUB(j)  (1280 + 64 * (j))
#define XB_XGEN(j)  (2304 + 64 * (j))
#define XB_TOP      3328
#define XB_TOPGEN   3392
#define XCD_BAR_WORDS 3456
#define XB_SPIN_CAP (1u << 22)
#define LAS __attribute__((address_space(3)))

DI unsigned xb_ld(unsigned* p)              { return __hip_atomic_load(p, __ATOMIC_RELAXED, __HIP_MEMORY_SCOPE_AGENT); }
DI unsigned xb_add(unsigned* p, unsigned v) { return __hip_atomic_fetch_add(p, v, __ATOMIC_RELAXED, __HIP_MEMORY_SCOPE_AGENT); }
DI unsigned xb_xcc_id() { return (unsigned)__builtin_amdgcn_s_getreg((3 << 11) | 20) & 0xFu; }
#define XB_SPIN(cond, bar) do { unsigned _sp = 0; while (cond) { __builtin_amdgcn_s_sleep(1); \
    if ((++_sp & 255u) == 0u) { if (xb_ld(&(bar)[XB_TMO])) break; if (_sp > XB_SPIN_CAP) { atomicAdd(&(bar)[XB_TMO], 1u); break; } } } } while (0)

struct XcdBarrier { unsigned* bar; unsigned x; volatile LAS unsigned* st; };

DI XcdBarrier xcd_barrier_post(unsigned* bar, volatile LAS unsigned* st) {
    XcdBarrier b; b.bar = bar; b.x = xb_xcc_id(); b.st = st;
    if (threadIdx.x == 0) (void)xb_add(&bar[XB_XCNT(b.x)], 1u);
    return b;
}
DI void xcd_barrier_complete(unsigned* bar, unsigned x, unsigned& nloc, unsigned& nx) {
    const unsigned G = gridDim.x * gridDim.y * gridDim.z;
    unsigned sum, cnt, mine, sp = 0u;
    for (;;) {
        sum = 0u; cnt = 0u; mine = 0u;
#pragma unroll
        for (unsigned j = 0; j < 16; ++j) { const unsigned c = xb_ld(&bar[XB_XCNT(j)]); sum += c; cnt += (c > 0u) ? 1u : 0u; mine = (j == x) ? c : mine; }
        if (sum == G) break;
        __builtin_amdgcn_s_sleep(1);
        if ((++sp & 255u) == 0u) { if (xb_ld(&bar[XB_TMO])) break; if (sp > XB_SPIN_CAP) { atomicAdd(&bar[XB_TMO], 1u); break; } }
    }
    nloc = mine > 0u ? mine : 1u; nx = cnt > 0u ? cnt : 1u;
}
DI void xcd_barrier(const XcdBarrier& b) {
    asm volatile("s_waitcnt vmcnt(0)" ::: "memory");
    __syncthreads();
    if (threadIdx.x == 0) {
        unsigned* bar = b.bar;
        __builtin_amdgcn_s_waitcnt(0);
        unsigned nloc = b.st[0], nx = b.st[1];
        if (nloc == 0u) { xcd_barrier_complete(bar, b.x, nloc, nx); b.st[0] = nloc; b.st[1] = nx; }
        const unsigned old = xb_add(&bar[XB_XSUB(b.x)], 1u);
        const unsigned gen = old / nloc;
        if (old + 1u == (gen + 1u) * nloc) {
            __builtin_amdgcn_fence(__ATOMIC_RELEASE, "agent");
            asm volatile("s_waitcnt vmcnt(0)" ::: "memory");
            const unsigned og = xb_add(&bar[XB_TOP], 1u);
            const unsigned tg = og / nx;
            if (og + 1u == (tg + 1u) * nx) xb_add(&bar[XB_TOPGEN], 1u);
            else XB_SPIN(xb_ld(&bar[XB_TOPGEN]) == tg, bar);
            __builtin_amdgcn_fence(__ATOMIC_ACQUIRE, "agent");
            xb_add(&bar[XB_XGEN(b.x)], 1u);
            asm volatile("s_waitcnt vmcnt(0)" ::: "memory");
        } else {
            XB_SPIN(xb_ld(&bar[XB_XGEN(b.x)]) == gen, bar);
            __builtin_amdgcn_fence(__ATOMIC_ACQUIRE, "agent");
            asm volatile("s_waitcnt vmcnt(0)" ::: "memory");
        }
    }
    __syncthreads();
}

constexpr int BK = 64, HALF = 128, HT = HALF * BK;
DI int lds_byte(int r, int c) { int st = (r >> 4) * 2 + (c >> 5), rr = r & 15, cc = c & 31, ob = rr * 64 + cc * 2; return st * 1024 + (ob ^ (((ob >> 9) & 1) << 5)); }
DI void stage_rc(int b, int& R, int& C) { int st = b / 1024, sb = b % 1024, swz = sb ^ (((sb >> 9) & 1) << 5); R = (st >> 1) * 16 + swz / 64; C = (st & 1) * 32 + (swz % 64) / 2; }

DI int blk_off(int row, int ld, int kt) { return (((row >> 8) * (ld >> 6) + kt) * 256 + (row & 255)) * 64; }
template <bool ABLK = false, bool BBLK = false, bool AGATHER = false>
DI void gemm256(const u16* __restrict__ A, long lda, int ar0, int ar1, int ar2, int ar3,
                const u16* __restrict__ Bt, long ldb, int bcol, int nt, u16* shm, f32x4 (&acc)[2][2][4][2], int kt0 = 0) {
  #define SA(b,h) (shm + ((b) * 2 + (h)) * HT)
  #define SB(b,h) (shm + (4 + (b) * 2 + (h)) * HT)
  #define GLDS(g, l) __builtin_amdgcn_global_load_lds((const unsigned*)(g), (__attribute__((address_space(3))) unsigned*)(l), 16, 0, 0)
  #define STAGE_A(TT, Pp, hh, kt) do { const char* _b = (const char*)A + (size_t)((kt) + kt0) * stepA; \
      GLDS(_b + OFFA((hh) * 2), (char*)(Pp) + (TT) * 16); \
      GLDS(_b + OFFA((hh) * 2 + 1), (char*)(Pp) + (TT) * 16 + 8192); } while (0)
  #define STAGE_B(TT, Pp, hh, kt) do { const char* _b = (const char*)Bt + (size_t)((kt) + kt0) * stepB; \
      GLDS(_b + (offB0 + (unsigned)((hh) * 2) * rowsB), (char*)(Pp) + (TT) * 16); \
      GLDS(_b + (offB0 + (unsigned)((hh) * 2 + 1) * rowsB), (char*)(Pp) + (TT) * 16 + 8192); } while (0)
  #define LDA(dst,b,h) for (int m = 0; m < 4; ++m) for (int k = 0; k < 2; ++k) \
      dst[m][k] = *reinterpret_cast<const bf16x8*>((char*)SA(b,h) + lds_byte(wr * 64 + m * 16 + fr, k * 32 + fq * 8))
  #define LDB(dst,b,h) for (int n = 0; n < 2; ++n) for (int k = 0; k < 2; ++k) \
      dst[n][k] = *reinterpret_cast<const bf16x8*>((char*)SB(b,h) + lds_byte(wc * 32 + n * 16 + fr, k * 32 + fq * 8))
  #define MMA(ai,bj,At,Bf) do { __builtin_amdgcn_s_setprio(1); \
      for (int m = 0; m < 4; ++m) for (int n = 0; n < 2; ++n) for (int k = 0; k < 2; ++k) \
        acc[ai][bj][m][n] = __builtin_amdgcn_mfma_f32_16x16x32_bf16(At[m][k], Bf[n][k], acc[ai][bj][m][n], 0, 0, 0); \
      __builtin_amdgcn_s_setprio(0); } while (0)
  #define WAIT_V(n) asm volatile("s_waitcnt vmcnt(" #n ")" ::: "memory")
  #define WAIT_L(n) asm volatile("s_waitcnt lgkmcnt(" #n ")" ::: "memory")
  #define BAR __builtin_amdgcn_s_barrier()
  #define SCHED __builtin_amdgcn_sched_barrier(0)
  int tx = threadIdx.x; asm volatile("" : "+v"(tx));
  int wid = tx >> 6, lane = tx & 63, wr = wid >> 2, wc = wid & 3, fr = lane & 15, fq = lane >> 4;
  unsigned offA0, offA1 = 0, offA2 = 0, offA3 = 0, offB0;
  const unsigned stepA = ABLK ? 32768u : 128u, stepB = BBLK ? 32768u : 128u;
  const unsigned rowsA = ABLK ? 8192u : (unsigned)lda * 128u, rowsB = BBLK ? 8192u : (unsigned)ldb * 128u;
  {
    int _r, _c; stage_rc(tx * 16, _r, _c);
    #define ROW_OFF(BLK, row, ld) ((unsigned)((BLK) ? blk_off((row), (int)(ld), 0) : (row) * (int)(ld)) * 2u + (unsigned)_c * 2u)
    offA0 = ROW_OFF(ABLK, ar0, lda);
    if (AGATHER) { offA1 = ROW_OFF(ABLK, ar1, lda); offA2 = ROW_OFF(ABLK, ar2, lda); offA3 = ROW_OFF(ABLK, ar3, lda); }
    offB0 = ROW_OFF(BBLK, bcol + _r, ldb);
    #undef ROW_OFF
  }
  #define OFFA(k) (AGATHER ? ((k) == 0 ? offA0 : (k) == 1 ? offA1 : (k) == 2 ? offA2 : offA3) : offA0 + (unsigned)(k) * rowsA)
#pragma unroll
  for (int a = 0; a < 2; ++a)
#pragma unroll
    for (int b = 0; b < 2; ++b)
#pragma unroll
      for (int m = 0; m < 4; ++m)
#pragma unroll
        for (int n = 0; n < 2; ++n) acc[a][b][m][n] = f32x4{0.f, 0.f, 0.f, 0.f};
  bf16x8 At[4][2], B0[2][2], B1[2][2];
  STAGE_B(tx, SB(0,0), 0, 0); STAGE_A(tx, SA(0,0), 0, 0);
  STAGE_B(tx, SB(0,1), 1, 0); STAGE_A(tx, SA(0,1), 1, 0);
  if (wr == 1) BAR;
  WAIT_V(4); BAR;
  STAGE_B(tx, SB(1,0), 0, 1); STAGE_A(tx, SA(1,0), 0, 1); STAGE_B(tx, SB(1,1), 1, 1);
  WAIT_V(6); BAR;
  for (int t = 0; t < nt - 2; t += 2) {
    LDB(B0,0,0); SCHED; LDA(At,0,0); STAGE_A(tx, SA(1,1), 1, t + 1);
    WAIT_L(8); BAR; WAIT_L(0); MMA(0,0,At,B0); BAR; SCHED;
    LDB(B1,0,1); STAGE_B(tx, SB(0,0), 0, t + 2);
    BAR; WAIT_L(0); MMA(0,1,At,B1); BAR;
    LDA(At,0,1); STAGE_A(tx, SA(0,0), 0, t + 2);
    BAR; WAIT_L(0); MMA(1,0,At,B0); BAR; SCHED;
    STAGE_B(tx, SB(0,1), 1, t + 2);
    WAIT_V(6); BAR; MMA(1,1,At,B1); BAR;
    LDB(B0,1,0); SCHED; LDA(At,1,0); STAGE_A(tx, SA(0,1), 1, t + 2);
    WAIT_L(8); BAR; WAIT_L(0); MMA(0,0,At,B0); BAR; SCHED;
    LDB(B1,1,1); STAGE_B(tx, SB(1,0), 0, t + 3);
    BAR; WAIT_L(0); MMA(0,1,At,B1); BAR;
    LDA(At,1,1); STAGE_A(tx, SA(1,0), 0, t + 3);
    BAR; WAIT_L(0); MMA(1,0,At,B0); BAR; SCHED;
    STAGE_B(tx, SB(1,1), 1, t + 3);
    WAIT_V(6); BAR; MMA(1,1,At,B1); BAR;
  }
  int tz = threadIdx.x; asm volatile("" : "+v"(tz)); wid = tz >> 6; lane = tz & 63; wr = wid >> 2; wc = wid & 3; fr = lane & 15; fq = lane >> 4;
  { LDB(B0,0,0); WAIT_V(0); LDA(At,0,0); STAGE_A(tz, SA(1,1), 1, nt - 1);
    BAR; WAIT_L(0); MMA(0,0,At,B0); BAR;
    LDB(B1,0,1); BAR; WAIT_L(0); MMA(0,1,At,B1); BAR;
    LDA(At,0,1); WAIT_V(4); BAR; WAIT_L(0); MMA(1,0,At,B0); MMA(1,1,At,B1); BAR; }
  { LDB(B0,1,0); LDA(At,1,0); WAIT_V(2); BAR; WAIT_L(0); MMA(0,0,At,B0); BAR;
    LDB(B1,1,1); WAIT_V(0); BAR; WAIT_L(0); MMA(0,1,At,B1); BAR;
    LDA(At,1,1); BAR; WAIT_L(0); MMA(1,0,At,B0); MMA(1,1,At,B1); BAR; }
  if (wr == 0) BAR;
  __syncthreads();
}
#define EPI_COORDS int e_tz = threadIdx.x; asm volatile("" : "+v"(e_tz)); const int e_wid = e_tz >> 6, e_lane = e_tz & 63; \
    const int wr = e_wid >> 2, wc = e_wid & 3, fr = e_lane & 15, fq = e_lane >> 4; (void)wr; (void)wc; (void)fr; (void)fq;
#define EPI_LOOP _Pragma("unroll") for (int ai = 0; ai < 2; ++ai) _Pragma("unroll") for (int bj = 0; bj < 2; ++bj) \
    _Pragma("unroll") for (int m = 0; m < 4; ++m) _Pragma("unroll") for (int n = 0; n < 2; ++n)
DI bool tile_map(int u, int nrt, int nct, int& rt, int& ct) {
  const int G = gridDim.x, N = nrt * nct;
  int v = u;
  if ((G & 7) == 0) { const int r = u / G, w = u - r * G; v = r * G + (w & 7) * (G >> 3) + (w >> 3); }
  if (v >= N) return false;
  const int band = 8 * nct, g = v / band, rem = v - g * band;
  const int rows = min(8, nrt - 8 * g);
  rt = 8 * g + rem % rows; ct = rem / rows;
  return true;
}
DI int tile_slots(int N) { const int G = gridDim.x; return (N + G - 1) / G * G; }
DI void plain_rows(int brow, int& a0, int& a1, int& a2, int& a3) { int tz = threadIdx.x; asm volatile("" : "+v"(tz)); int r, c; stage_rc(tz * 16, r, c); a0 = brow + r; a1 = brow + r + 64; a2 = brow + r + 128; a3 = brow + r + 192; }
#include <utility>
struct CvtJob { const float* src; long lds_; int n0, Nreal; u16* dst; long ldd; int dmode, tk, tn; bool blk; };
DI void cvt_load(const CvtJob& J, float4 (&v)[8], int tid) {
#pragma unroll
  for (int i = 0; i < 8; ++i) {
    const int k = i * 8 + (tid >> 6), n = J.tn * 256 + (tid & 63) * 4;
    v[i] = make_float4(0.f, 0.f, 0.f, 0.f);
    if (n < J.Nreal) v[i] = *reinterpret_cast<const float4*>(J.src + (long)(J.tk * 64 + k) * J.lds_ + J.n0 + n);
  }
}
DI void cvt_to_lds(const float4 (&v)[8], float* tile, int tid) {
#pragma unroll
  for (int i = 0; i < 8; ++i) {
    const int k = i * 8 + (tid >> 6), n4 = (tid & 63) * 4;
    *reinterpret_cast<float4*>(tile + k * 260 + ((n4 + 4 * (k >> 3)) & 255)) = v[i];
  }
}
DI void cvt_store(const CvtJob& J, const float* tile, int tid) {
#pragma unroll
  for (int i = 0; i < 4; ++i) {
    const int nl = i * 64 + (tid >> 3), q = tid & 7, k8 = q * 8;
    const int n = J.tn * 256 + nl;
    const int cc = (nl + 4 * q) & 255;
    unsigned o[4];
#pragma unroll
    for (int j = 0; j < 4; ++j) o[j] = pk2(tile[(k8 + 2 * j) * 260 + cc], tile[(k8 + 2 * j + 1) * 260 + cc]);
    const int drow = J.dmode == 0 ? n : ((n >> 7) * 256 + (n & 127) + (J.dmode == 2 ? 128 : 0));
    *reinterpret_cast<uint4*>(J.dst + (J.blk ? blk_off(drow, (int)J.ldd, J.tk) : (long)drow * J.ldd + J.tk * 64) + k8) = make_uint4(o[0], o[1], o[2], o[3]);
  }
}
DI void cvt_decode(const P& p, int g, CvtJob& J) {
  char* ws = p.ws;
  J.n0 = 0; J.dmode = 0; J.blk = true;
  if (g < 1312) {
    const int l = g / 656, r = g % 656;
    char* wl = ws + OFF_W + l * WL_SIZE;
    const float* w_in = p.w_in + (size_t)l * D_ * INW;
    if (r < 192)      { J.src = w_in; J.lds_ = INW; J.Nreal = 2840; J.dst = (u16*)(wl + WL_WINT); J.ldd = 1024; J.tk = r % 16; J.tn = r / 16; }
    else if (r < 384) { J.src = w_in; J.lds_ = INW; J.n0 = 2840; J.Nreal = 3072; J.dst = (u16*)(wl + WL_WGT); J.ldd = 1024; J.tk = (r - 192) % 16; J.tn = (r - 192) / 16; }
    else if (r < 416) { J.src = p.w_sg_out + (size_t)l * 512 * 1024; J.lds_ = 1024; J.Nreal = 1024; J.dst = (u16*)(wl + WL_WSG); J.ldd = 512; J.tk = (r - 384) % 8; J.tn = (r - 384) / 8; }
    else if (r < 448) { J.src = p.w_nsa_out + (size_t)l * 512 * 1024; J.lds_ = 1024; J.Nreal = 1024; J.dst = (u16*)(wl + WL_WNSA); J.ldd = 512; J.tk = (r - 416) % 8; J.tn = (r - 416) / 8; }
    else if (r < 512) { J.src = p.w_out + (size_t)l * 1024 * 1024; J.lds_ = 1024; J.Nreal = 1024; J.dst = (u16*)(wl + WL_WOUT); J.ldd = 1024; J.tk = (r - 448) % 16; J.tn = (r - 448) / 16; }
    else if (r < 576) { J.src = p.ple_gw + (size_t)l * 1024 * 1024; J.lds_ = 1024; J.Nreal = 1024; J.dst = (u16*)(wl + WL_WPG); J.ldd = 1024; J.tk = (r - 512) % 16; J.tn = (r - 512) / 16; }
    else if (r < 592) { J.src = p.ple_pj + (size_t)l * 256 * 1024; J.lds_ = 1024; J.Nreal = 1024; J.dst = (u16*)(wl + WL_WPP); J.ldd = 256; J.tk = (r - 576) % 4; J.tn = (r - 576) / 4; }
    else if (r < 624) { J.src = p.ck_w1 + (size_t)l * 2048 * 256; J.lds_ = 256; J.Nreal = 256; J.dst = (u16*)(wl + WL_W1K); J.ldd = 2048; J.tk = r - 592; J.tn = 0; J.blk = false; }
    else              { J.src = p.cv_w1 + (size_t)l * 2048 * 256; J.lds_ = 256; J.Nreal = 256; J.dst = (u16*)(wl + WL_W1V); J.ldd = 2048; J.tk = r - 624; J.tn = 0; J.blk = false; }
  } else {
    const int g2 = g - 1312, e = g2 / 528, r = g2 % 528, which = r / 176, t = r % 176;
    char* we = ws + OFF_WFFN + (size_t)e * FFN_E_SIZE;
    J.src = which == 0 ? (e == 0 ? p.ffn_g : p.moe_g + (size_t)(e - 1) * D_ * DFF)
          : which == 1 ? (e == 0 ? p.ffn_u : p.moe_u + (size_t)(e - 1) * D_ * DFF)
                       : (e == 0 ? p.ffn_d : p.moe_d + (size_t)(e - 1) * D_ * DFF);
    if (which < 2) { J.lds_ = DFF; J.Nreal = DFF; J.dst = (u16*)we; J.ldd = 1024; J.dmode = 1 + which; J.tk = t % 16; J.tn = t / 16; }
    else           { J.lds_ = 1024; J.Nreal = 1024; J.dst = (u16*)(we + (size_t)5632 * 1024 * 2); J.ldd = DFF; J.tk = t % 44; J.tn = t / 44; }
  }
}

DI void prologue_phase(const P& p, char* smem) {
  float* tile = reinterpret_cast<float*>(smem);
  char* ws = p.ws;
  const int tid = tid_opaque();
  const long gtid = (long)blockIdx.x * NTHR + tid, gsz = (long)gridDim.x * NTHR;
  for (int u = blockIdx.x; u < 192; u += gridDim.x) {
    if (u < 128) {
      const int l = u >> 6, g = (u >> 4) & 3, nt = u & 15;
      float* sW = tile;
      float* sP = tile + 128 * 64;
      const float* pw = p.pool_w + (size_t)l * 4 * 128 * 128;
      const float* sc = p.pool_scale + (size_t)l * 512;
      const float* wo = p.w_pool_out + (size_t)l * 512 * 1024;
      u16* dst = (u16*)(ws + OFF_W + l * WL_SIZE + WL_WEFF);
      __syncthreads();
      for (int i = tid; i < 128 * 64; i += NTHR) { const int d = i >> 6, n = i & 63; sW[i] = sc[g * 128 + d] * wo[(size_t)(g * 128 + d) * 1024 + nt * 64 + n]; }
      for (int i = tid; i < 128 * 128; i += NTHR) sP[i] = pw[(size_t)g * 128 * 128 + i];
      __syncthreads();
      const int n = tid & 63, c0 = (tid >> 6) * 16;
      float a[16];
#pragma unroll
      for (int j = 0; j < 16; ++j) a[j] = 0.f;
      for (int d = 0; d < 128; ++d) {
        const float w = sW[d * 64 + n];
#pragma unroll
        for (int j = 0; j < 16; ++j) a[j] += sP[(c0 + j) * 128 + d] * w;
      }
      unsigned o[8];
#pragma unroll
      for (int j = 0; j < 8; ++j) o[j] = pk2(a[2 * j], a[2 * j + 1]);
      uint4* q = reinterpret_cast<uint4*>(dst + blk_off(nt * 64 + n, 512, (g * 128 + c0) >> 6) + ((g * 128 + c0) & 63));
      q[0] = make_uint4(o[0], o[1], o[2], o[3]); q[1] = make_uint4(o[4], o[5], o[6], o[7]);
    } else if (u < 192) {
      const int v = u - 128, l = v >> 5, kv = (v >> 4) & 1, sg = v & 15;
      {
        const float* pos = (kv == 0 ? p.ck_pos : p.cv_pos) + (size_t)l * 2048 + sg * 128;
        const float* w1 = (kv == 0 ? p.ck_w1 : p.cv_w1) + (size_t)l * 2048 * 256 + (size_t)sg * 128 * 256;
        const int c = tid & 255, hf = tid >> 8;
        float s = 0.f;
#pragma unroll 8
        for (int k = hf * 64; k < hf * 64 + 64; ++k) s += pos[k] * w1[(size_t)k * 256 + c];
        __syncthreads();
        tile[tid] = s;
        __syncthreads();
        if (tid < 256) reinterpret_cast<float*>(ws + OFF_POSB)[((l * 2 + kv) * 16 + sg) * 256 + tid] = tile[tid] + tile[tid + 256];
      }
    }
  }
  {
    const int NT = 6064, G = gridDim.x;
    int g = blockIdx.x;
    CvtJob J, Jn;
    float4 v[8];
    if (g < NT) { cvt_decode(p, g, J); cvt_load(J, v, tid); }
    while (g < NT) {
      const int gn = g + G;
      __syncthreads();
      cvt_to_lds(v, tile, tid);
      __syncthreads();
      if (gn < NT) { cvt_decode(p, gn, Jn); cvt_load(Jn, v, tid); }
      cvt_store(J, tile, tid);
      J = Jn; g = gn;
    }
    __syncthreads();
  }
  {
    const float4* src = reinterpret_cast<const float4*>(p.x);
    uint2* dst = reinterpret_cast<uint2*>(ws + OFF_XB);
    const long N4 = (long)T_ * D_ / 4;
    float4 v[4];
#pragma unroll
    for (int j = 0; j < 4; ++j) { const long ii = gtid + j * gsz; v[j] = ii < N4 ? src[ii] : make_float4(0.f, 0.f, 0.f, 0.f); }
    for (long i = gtid; i < N4; i += 4 * gsz) {
      float4 w4[4];
#pragma unroll
      for (int j = 0; j < 4; ++j) { const long ii = i + 4 * gsz + j * gsz; w4[j] = ii < N4 ? src[ii] : make_float4(0.f, 0.f, 0.f, 0.f); }
#pragma unroll
      for (int j = 0; j < 4; ++j) {
        const long ii = i + j * gsz;
        if (ii < N4) {
          const int row = (int)(ii >> 8), col = (int)(ii & 255) * 4;
          *reinterpret_cast<uint2*>((u16*)(ws + OFF_XB) + blk_off(row, 1024, col >> 6) + (col & 63)) = make_uint2(pk2(v[j].x, v[j].y), pk2(v[j].z, v[j].w));
        }
      }
#pragma unroll
      for (int j = 0; j < 4; ++j) v[j] = w4[j];
    }
  }
  {
    float* rope = reinterpret_cast<float*>(ws + OFF_ROPE);
    for (long i = gtid; i < (long)T_ * 8; i += gsz) {
      const int t = (int)(i >> 3), k = (int)(i & 7);
      const float inv = k == 0 ? 1.0f : k == 1 ? 0.1939227432012558f : k == 2 ? 0.03760603070259094f : k == 3 ? 0.007292664609849453f
                      : k == 4 ? 0.0014142135623842478f : k == 5 ? 0.00027424818836152554f : k == 6 ? 5.3182957344688475e-05f : 1.0313385246263351e-05f;
      const float ang = (float)p.pos[t] * inv;
      const double a = (double)ang;
      const double rr = a - 6.283185307179586 * rint(a * 0.15915494309189535);
      const float r = (float)rr;
      rope[t * 16 + k] = __cosf(r); rope[t * 16 + 8 + k] = __sinf(r);
    }
  }
  for (int l = 0; l < 2; ++l) {
    const float* sgw = p.sg_w + (size_t)l * 4 * 128 * 128;
    u16* d = (u16*)(ws + OFF_W + l * WL_SIZE + WL_SGW);
    for (long i = gtid; i < 4 * 128 * 128; i += gsz) { const int s = (int)(i & 127), t = (int)((i >> 7) & 127); d[i] = f2bf(s <= t ? sgw[i] : 0.f); }
  }
}
DI f32x16 mfma32(bf16x8 a, bf16x8 b, f32x16 c) { return __builtin_amdgcn_mfma_f32_32x32x16_bf16(a, b, c, 0, 0, 0); }
DI f32x4  mfma16(bf16x8 a, bf16x8 b, f32x4 c)  { return __builtin_amdgcn_mfma_f32_16x16x32_bf16(a, b, c, 0, 0, 0); }

DI void ph1_proj(const P& p, int l, char* smem) {
  char* ws = p.ws;
  const u16* XB = (const u16*)(ws + OFF_XB);
  const u16* WinT = (const u16*)(ws + OFF_W + l * WL_SIZE + WL_WINT);
  const float* rope = (const float*)(ws + OFF_ROPE);
  for (int u = blockIdx.x; u < tile_slots(128 * 12); u += gridDim.x) {
    int rt, ct; if (!tile_map(u, 128, 12, rt, ct)) continue;
    const int brow = rt * 256;
    int a0, a1, a2, a3; plain_rows(brow, a0, a1, a2, a3);
    f32x4 acc[2][2][4][2];
    gemm256<true, true>(XB, 1024, a0, a1, a2, a3, WinT, 1024, ct * 256, 16, (u16*)smem, acc);
    EPI_COORDS
    const int b = brow / S_, s0 = brow % S_;
    if (ct >= 6 && ct < 11 && (wc & 1) == 0) {
#pragma unroll
      for (int ai = 0; ai < 2; ++ai) {
        float cs[4][4], sn[4][4];
#pragma unroll
        for (int m = 0; m < 4; ++m)
#pragma unroll
          for (int j = 0; j < 4; ++j) {
            const size_t row = (size_t)(brow + ai * 128 + wr * 64 + m * 16 + fq * 4 + j);
            cs[m][j] = rope[row * 16 + (fr & 7)]; sn[m][j] = rope[row * 16 + 8 + (fr & 7)];
          }
#pragma unroll
        for (int bj = 0; bj < 2; ++bj) {
          if (ct < 8 || bj == 0) {
#pragma unroll
            for (int m = 0; m < 4; ++m)
#pragma unroll
              for (int j = 0; j < 4; ++j) {
                const float v = acc[ai][bj][m][0][j], pv = __shfl_xor(v, 8);
                acc[ai][bj][m][0][j] = fr < 8 ? v * cs[m][j] - pv * sn[m][j] : v * cs[m][j] + pv * sn[m][j];
              }
          }
        }
      }
    }
    if (ct < 6) {
      u16* dst = (u16*)(ws + (ct < 2 ? RB_A : ct < 4 ? RB_GU : RB_GV));
      u16* AH = (u16*)(ws + OFF_AH);
      const int cb = (ct & 1) * 256;
      EPI_LOOP {
        const int col = cb + bj * 128 + wc * 32 + n * 16 + fr;
#pragma unroll
        for (int j = 0; j < 4; ++j) {
          const int row = brow + ai * 128 + wr * 64 + m * 16 + fq * 4 + j;
          float v = acc[ai][bj][m][n][j];
          if (ct >= 2) v = fgelu(v);
          const u16 hv = f2bf(v);
          dst[(size_t)row * 512 + col] = hv;
          if (ct < 2 && wr == 1 && m == 3 && (fq * 4 + j) >= 1) AH[((size_t)(row >> 7) * 16 + (fq * 4 + j)) * 512 + col] = hv;
        }
      }
    } else if (ct < 8) {
      u16* Q = (u16*)(ws + RB_Q);
      EPI_LOOP {
        const int head = (ct - 6) * 4 + bj * 2 + (wc >> 1), d = (wc & 1) * 32 + n * 16 + fr;
#pragma unroll
        for (int j = 0; j < 4; ++j) {
          const int row = brow + ai * 128 + wr * 64 + m * 16 + fq * 4 + j;
          const float v = acc[ai][bj][m][n][j];
          Q[(size_t)row * 512 + head * 64 + d] = f2bf(v * 0.18033688011112042f);
        }
      }
    } else if (ct < 11) {
      u16* Kd = (u16*)(ws + (ct == 8 ? RB_KC : ct == 9 ? RB_KS : RB_KW));
      u16* Vd = (u16*)(ws + (ct == 8 ? RB_VC : ct == 9 ? RB_VST : RB_VWT));
      EPI_LOOP {
        const int head = wc >> 1, d = (wc & 1) * 32 + n * 16 + fr;
        const int bh = b * 2 + head;
        const int sl = s0 + ai * 128 + wr * 64 + m * 16 + fq * 4;
        if (bj == 0) {
#pragma unroll
          for (int j = 0; j < 4; ++j) {
            const float v = acc[ai][bj][m][n][j];
            Kd[((size_t)bh * S_ + sl + j) * 64 + d] = f2bf(v);
          }
        } else if (ct == 8) {
#pragma unroll
          for (int j = 0; j < 4; ++j) Vd[((size_t)bh * S_ + sl + j) * 64 + d] = f2bf(acc[ai][bj][m][n][j]);
        } else {
          const int blk = sl >> 6;
          const int pos = ct == 9 ? (32 * (m >> 1) + 8 * fq + 4 * (m & 1)) : (16 * m + 8 * (fq & 1) + 4 * (fq >> 1));
          const f32x4 v = acc[ai][bj][m][n];
          *reinterpret_cast<uint2*>(Vd + (((size_t)bh * 256 + blk) * 64 + d) * 64 + pos) = make_uint2(pk2(v[0], v[1]), pk2(v[2], v[3]));
        }
      }
    } else {
      float* NG = (float*)(ws + OFF_NG);
      EPI_LOOP {
        if (bj == 0 && wc == 0) {
          const int col = n * 16 + fr;
          if (col < 24) {
#pragma unroll
            for (int j = 0; j < 4; ++j) {
              const int row = brow + ai * 128 + wr * 64 + m * 16 + fq * 4 + j;
              NG[(size_t)row * 24 + col] = fsigmoid(acc[ai][bj][m][n][j]);
            }
          }
        }
      }
    }
  }
}

DI void chunk_unit(const P& p, int l, int c, char* smem) {
  char* ws = p.ws;
  int tid_ = tid_opaque(); asm volatile("" : "+v"(tid_));
  const int tid = tid_, w = tid >> 6, lane = tid & 63;
  u16* A_ = (u16*)(ws + RB_A);
  const u16* AH = (const u16*)(ws + OFF_AH);
  u16* GU = (u16*)(ws + RB_GU);
  const u16* GV = (const u16*)(ws + RB_GV);
  const int R0 = c * 128, sseq0 = R0 % S_;
  {
    const int wsz = 2 << (lane >> 4);
    uint4* stg = reinterpret_cast<uint4*>(smem);
    const bool has_halo = sseq0 != 0;
#pragma unroll
    for (int i = 0; i < 18; ++i) {
      const int rl = w + 8 * i;
      if (rl < 143) {
        const int rr = rl - 15;
        uint4 v = make_uint4(0u, 0u, 0u, 0u);
        if (rr >= 0) v = *reinterpret_cast<const uint4*>(A_ + (size_t)(R0 + rr) * 512 + lane * 8);
        else if (has_halo) v = *reinterpret_cast<const uint4*>(AH + ((size_t)(c - 1) * 16 + 16 + rr) * 512 + lane * 8);
        stg[rl * 64 + lane] = v;
      }
    }
    __syncthreads();
#pragma unroll 1
    for (int ti = 0; ti < 16; ++ti) {
      const int tl = 16 * w + ti, sq = sseq0 + tl;
      float s8[8], cur[8];
#pragma unroll
      for (int e = 0; e < 8; ++e) { s8[e] = 0.f; cur[e] = 0.f; }
      const int nj = min(sq + 1, wsz);
      for (int j = 0; j < nj; ++j) {
        const uint4 raw = stg[(tl + 15 - j) * 64 + lane];
        const unsigned rw[4] = {raw.x, raw.y, raw.z, raw.w};
#pragma unroll
        for (int e = 0; e < 4; ++e) {
          const float lo = bflo(rw[e]), hi = bfhi(rw[e]);
          s8[2 * e] += lo; s8[2 * e + 1] += hi;
          if (j == 0) { cur[2 * e] = lo; cur[2 * e + 1] = hi; }
        }
      }
      const float inv = 1.f / (float)nj;
      *reinterpret_cast<uint4*>((u16*)(ws + RB_DB) + blk_off(R0 + tl, 512, lane >> 3) + (lane & 7) * 8) =
          make_uint4(pk2(s8[0] * inv - cur[0], s8[1] * inv - cur[1]), pk2(s8[2] * inv - cur[2], s8[3] * inv - cur[3]),
                     pk2(s8[4] * inv - cur[4], s8[5] * inv - cur[5]), pk2(s8[6] * inv - cur[6], s8[7] * inv - cur[7]));
    }
  }
  float* st_mu = reinterpret_cast<float*>(smem);
  float* st_rs = st_mu + 128;
  u16* VT = reinterpret_cast<u16*>(smem + 1024);
  const float* lg = p.sg_ln_g + (size_t)l * 512;
  const float* lb = p.sg_ln_b + (size_t)l * 512;
  const float* sgb = p.sg_b + (size_t)l * 512;
  const u16* SGW = (const u16*)(ws + OFF_W + l * WL_SIZE + WL_SGW);
  __syncthreads();
#pragma unroll 1
  for (int t4 = 0; t4 < 16; t4 += 4) {
    uint4 raw4[4];
#pragma unroll
    for (int q = 0; q < 4; ++q) raw4[q] = *reinterpret_cast<const uint4*>(GV + (size_t)(R0 + 16 * w + t4 + q) * 512 + lane * 8);
#pragma unroll
    for (int q = 0; q < 4; ++q) {
      const int tl = 16 * w + t4 + q;
      const unsigned rw[4] = {raw4[q].x, raw4[q].y, raw4[q].z, raw4[q].w};
      float x[8];
#pragma unroll
      for (int e = 0; e < 4; ++e) { x[2 * e] = bflo(rw[e]); x[2 * e + 1] = bfhi(rw[e]); }
      float s = 0.f;
#pragma unroll
      for (int e = 0; e < 8; ++e) s += x[e];
      const float mu = wave_sum(s) * (1.f / 512.f);
      float v = 0.f;
#pragma unroll
      for (int e = 0; e < 8; ++e) { const float d = x[e] - mu; v += d * d; }
      const float var = wave_sum(v) * (1.f / 512.f);
      if (lane == 0) { st_mu[tl] = mu; st_rs[tl] = rsqrtf(var + 1e-5f); }
    }
  }
  __syncthreads();
  const int fr = lane & 15, fq = lane >> 4;
#pragma unroll 1
  for (int g = 0; g < 4; ++g) {
    const int nks = (w >> 1) + 1;
    bf16x8 afr[4];
#pragma unroll
    for (int ks = 0; ks < 4; ++ks)
      afr[ks] = *reinterpret_cast<const bf16x8*>(SGW + ((size_t)(g * 128 + 16 * w + fr)) * 128 + 32 * (ks < nks ? ks : 0) + 8 * fq);
    {
      const int sp = tid >> 3, cr = (tid & 7) * 16;
      const int sA = 2 * sp, sB = 2 * sp + 1;
      const float muA = st_mu[sA], rsA = st_rs[sA], muB = st_mu[sB], rsB = st_rs[sB];
      const uint4* pa = reinterpret_cast<const uint4*>(GV + (size_t)(R0 + sA) * 512 + g * 128 + cr);
      const uint4* pb = reinterpret_cast<const uint4*>(GV + (size_t)(R0 + sB) * 512 + g * 128 + cr);
      const uint4 ra0 = pa[0], ra1 = pa[1], rb0 = pb[0], rb1 = pb[1];
      const unsigned ua[8] = {ra0.x, ra0.y, ra0.z, ra0.w, ra1.x, ra1.y, ra1.z, ra1.w};
      const unsigned ub[8] = {rb0.x, rb0.y, rb0.z, rb0.w, rb1.x, rb1.y, rb1.z, rb1.w};
#pragma unroll
      for (int e = 0; e < 8; ++e) {
        const int c0 = cr + 2 * e;
        const float g0 = lg[g * 128 + c0], g1 = lg[g * 128 + c0 + 1], b0 = lb[g * 128 + c0], b1 = lb[g * 128 + c0 + 1];
        const float a0 = (bflo(ua[e]) - muA) * rsA * g0 + b0, a1 = (bfhi(ua[e]) - muA) * rsA * g1 + b1;
        const float q0 = (bflo(ub[e]) - muB) * rsB * g0 + b0, q1 = (bfhi(ub[e]) - muB) * rsB * g1 + b1;
        *reinterpret_cast<unsigned*>(VT + (size_t)c0 * 136 + sA) = pk2(a0, q0);
        *reinterpret_cast<unsigned*>(VT + (size_t)(c0 + 1) * 136 + sA) = pk2(a1, q1);
      }
    }
    __syncthreads();
    f32x4 acc[8];
#pragma unroll
    for (int nt = 0; nt < 8; ++nt) acc[nt] = f32x4{0.f, 0.f, 0.f, 0.f};
#pragma unroll
    for (int ks = 0; ks < 4; ++ks) {
      if (ks < nks) {
      const bf16x8 a = afr[ks];
#pragma unroll
      for (int nt = 0; nt < 8; ++nt) {
        const bf16x8 bb = *reinterpret_cast<const bf16x8*>(VT + (size_t)(16 * nt + fr) * 136 + 32 * ks + 8 * fq);
        acc[nt] = mfma16(a, bb, acc[nt]);
      }
      }
    }
    {
      u16 guv[8][4]; float sbv[4];
#pragma unroll
      for (int j = 0; j < 4; ++j) sbv[j] = sgb[g * 128 + 16 * w + 4 * fq + j];
#pragma unroll
      for (int nt = 0; nt < 8; ++nt)
#pragma unroll
        for (int j = 0; j < 4; ++j) guv[nt][j] = GU[(size_t)(R0 + 16 * w + 4 * fq + j) * 512 + g * 128 + 16 * nt + fr];
#pragma unroll
      for (int nt = 0; nt < 8; ++nt)
#pragma unroll
        for (int j = 0; j < 4; ++j) {
          const int t = 16 * w + 4 * fq + j, cc = g * 128 + 16 * nt + fr;
          ((u16*)(ws + RB_YB))[blk_off(R0 + t, 512, cc >> 6) + (cc & 63)] = f2bf(bf2f(guv[nt][j]) * (acc[nt][j] + sbv[j]));
        }
    }
    __syncthreads();
  }
}

DI void ph2_mix(const P& p, int l, char* smem) {
  char* ws = p.ws;
  for (int u = blockIdx.x; u < 64 + 256; u += gridDim.x) {
    if (u < 64) {
      const int kv = u >> 5, split = (u >> 4) & 1, rtile = u & 15, brow = rtile * 256;
      const u16* A = (const u16*)(ws + (kv ? RB_VC : RB_KC)) + split * 1024;
      const u16* Bt = (const u16*)(ws + OFF_W + l * WL_SIZE + (kv ? WL_W1V : WL_W1K)) + split * 1024;
      int a0, a1, a2, a3; plain_rows(brow, a0, a1, a2, a3);
      f32x4 acc[2][2][4][2];
      gemm256(A, 1024, a0, a1, a2, a3, Bt, 2048, 0, 16, (u16*)smem, acc);
      EPI_COORDS
      float* HID = (float*)(ws + RB_HID) + (size_t)(kv * 2 + split) * 4096 * 256;
      EPI_LOOP {
        const int col = bj * 128 + wc * 32 + n * 16 + fr;
#pragma unroll
        for (int j = 0; j < 4; ++j) {
          const int row = brow + ai * 128 + wr * 64 + m * 16 + fq * 4 + j;
          HID[(size_t)row * 256 + col] = acc[ai][bj][m][n][j];
        }
      }
    } else {
      chunk_unit(p, l, u - 64, smem);
    }
  }
}

DI void ph2b_cmp2(const P& p, int l, char* smem) {
  char* ws = p.ws;
  float* sH = reinterpret_cast<float*>(smem);
  float* sW2 = sH + 16 * 256;
  const int tid = tid_opaque();
  const float* posb = (const float*)(ws + OFF_POSB);
  for (int u = blockIdx.x; u < 512; u += gridDim.x) {
    const int kv = u >> 8, rb = u & 255;
    const float* w2 = (kv ? p.cv_w2 : p.ck_w2) + (size_t)l * 256 * 64;
    const float* H0 = (const float*)(ws + RB_HID) + (size_t)(kv * 2 + 0) * 4096 * 256;
    const float* H1 = (const float*)(ws + RB_HID) + (size_t)(kv * 2 + 1) * 4096 * 256;
    __syncthreads();
    for (int i = tid; i < 256 * 64; i += NTHR) sW2[i] = w2[i];
    for (int i = tid; i < 16 * 256; i += NTHR) {
      const size_t gi = (size_t)(rb * 16) * 256 + i;
      float pb = 0.f;
#pragma unroll
      for (int sg = 0; sg < 16; ++sg) pb += posb[((l * 2 + kv) * 16 + sg) * 256 + (i & 255)];
      sH[i] = fgelu(H0[gi] + H1[gi] + pb);
    }
    __syncthreads();
    const int row = tid >> 5, e2 = (tid & 31) * 2;
    float o0 = 0.f, o1 = 0.f;
    for (int c = 0; c < 256; ++c) { const float h = sH[row * 256 + c]; o0 += h * sW2[c * 64 + e2]; o1 += h * sW2[c * 64 + e2 + 1]; }
    const int R = rb * 16 + row, bh = R >> 10, i = R & 1023;
    if (kv == 0) {
      *reinterpret_cast<unsigned*>((u16*)(ws + OFF_KCMP) + ((size_t)bh * 1024 + i) * 64 + e2) = pk2(o0, o1);
    } else {
      const int key = i & 63, pos = 16 * (key >> 4) + 8 * ((key >> 2) & 1) + 4 * ((key >> 3) & 1) + (key & 3);
      u16* vt = (u16*)(ws + OFF_VCMPT) + ((size_t)(bh * 16 + (i >> 6)) * 64) * 64;
      vt[(size_t)e2 * 64 + pos] = f2bf(o0); vt[(size_t)(e2 + 1) * 64 + pos] = f2bf(o1);
    }
  }
}
DI int crow16(int i, int h) { return (i & 3) + 8 * (i >> 2) + 4 * h; }
DI bf16x8 pack8(float a0, float a1, float a2, float a3, float a4, float a5, float a6, float a7) {
  u32x4 r; r[0] = pk2(a0, a1); r[1] = pk2(a2, a3); r[2] = pk2(a4, a5); r[3] = pk2(a6, a7); return __builtin_bit_cast(bf16x8, r);
}
constexpr int ATT_REP_CMP1 = 1, ATT_REP_TOPK = 1, ATT_REP_WIN = 1, ATT_REP_SLC = 1;
constexpr int ATT_IMP = 0, ATT_RING = 0, ATT_SK = 66048, ATT_SV = ATT_SK + 9216,
              ATT_MSK = 131072, ATT_ULIST = ATT_MSK + 2048, ATT_UCNT = ATT_ULIST + 512, ATT_END = ATT_UCNT + 64;
static_assert(ATT_END <= 147456, "attention LDS map overflows");

DI uint4 att_gload(const u16* gsrc, int tid) { return *reinterpret_cast<const uint4*>(gsrc + (tid >> 3) * 64 + (tid & 7) * 8); }
DI void att_lstore(u16* sdst, uint4 v, int tid) { *reinterpret_cast<uint4*>(sdst + (tid >> 3) * 72 + (tid & 7) * 8) = v; }

DI void ph3_attn(const P& p, int l, char* smem) {
  char* ws = p.ws;
  const int tid = tid_opaque(), w = tid >> 6, lane = tid & 63;
  const int r = lane & 31, h = lane >> 5, ql = r >> 2, g = r & 3;
  u16* sK = reinterpret_cast<u16*>(smem + ATT_SK);
  u16* sV = reinterpret_cast<u16*>(smem + ATT_SV);
  float* imp = reinterpret_cast<float*>(smem + ATT_IMP);
  unsigned char* msk = reinterpret_cast<unsigned char*>(smem + ATT_MSK) + w * 256;
  unsigned short* ulist = reinterpret_cast<unsigned short*>(smem + ATT_ULIST);
  int* ucnt = reinterpret_cast<int*>(smem + ATT_UCNT);
  char* ring = smem + ATT_RING;
  const u16* Q = (const u16*)(ws + RB_Q);
  const u16* KCMP = (const u16*)(ws + OFF_KCMP);
  const u16* VCMPT = (const u16*)(ws + OFF_VCMPT);
  const u16* KS = (const u16*)(ws + RB_KS);
  const u16* VST = (const u16*)(ws + RB_VST);
  const u16* KW = (const u16*)(ws + RB_KW);
  const u16* VWT = (const u16*)(ws + RB_VWT);
  const float* NG = (const float*)(ws + OFF_NG);
  u16* O = (u16*)(ws + RB_O);

  for (int u = blockIdx.x; u < 1024; u += gridDim.x) {
    const int bh = u >> 8, wq = u & 255, qt = (bh & 1) ? 255 - wq : wq;
    const int b = bh >> 1, hkv = bh & 1, q0 = qt * 64;
    const int t = q0 + 8 * w + ql, head = hkv * 4 + g;
    const size_t tok = (size_t)b * S_ + t;
    bf16x8 Qf[4];
#pragma unroll
    for (int ks = 0; ks < 4; ++ks) Qf[ks] = *reinterpret_cast<const bf16x8*>(Q + tok * 512 + head * 64 + 16 * ks + 8 * h);
    const float gc = NG[tok * 24 + head * 3 + 0], gw = NG[tok * 24 + head * 3 + 2];
    __syncthreads();
    for (int i = tid; i < 64 * 257; i += NTHR) imp[i] = 0.f;
    reinterpret_cast<unsigned*>(smem + ATT_MSK)[tid] = 0u;
    __syncthreads();

    const int nk = q0 / 16 + 3, ntile = (nk + 63) >> 6;
    float m1 = -1e30f, l1 = 0.f;
#pragma unroll 1
    for (int rep = 0; rep < ATT_REP_CMP1; ++rep) { m1 = -1e30f; l1 = 0.f;
    uint4 rk = att_gload(KCMP + ((size_t)bh * 1024) * 64, tid);
    for (int kt = 0; kt < ntile; ++kt) {
      __syncthreads();
      att_lstore(sK, rk, tid);
      rk = att_gload(KCMP + ((size_t)bh * 1024 + 64 * (kt + 1 < ntile ? kt + 1 : kt)) * 64, tid);
      __syncthreads();
#pragma unroll
      for (int kh = 0; kh < 2; ++kh) {
        f32x16 sa;
#pragma unroll
        for (int i = 0; i < 16; ++i) sa[i] = 0.f;
#pragma unroll
        for (int ks = 0; ks < 4; ++ks) sa = mfma32(*reinterpret_cast<const bf16x8*>(sK + (32 * kh + r) * 72 + 16 * ks + 8 * h), Qf[ks], sa);
        float tm = -1e30f;
#pragma unroll
        for (int i = 0; i < 16; ++i) { const int key = 64 * kt + 32 * kh + crow16(i, h); if (16 * key + 31 <= t) tm = fmaxf(tm, sa[i]); }
        const float mn = fmaxf(m1, tm);
        float sum = 0.f;
#pragma unroll
        for (int i = 0; i < 16; ++i) { const int key = 64 * kt + 32 * kh + crow16(i, h); if (16 * key + 31 <= t) sum += __builtin_amdgcn_exp2f(sa[i] - mn); }
        l1 = l1 * __builtin_amdgcn_exp2f(m1 - mn) + sum; m1 = mn;
      }
    }
    }
    float Mx, invL;
    {
      const float mo = __shfl_xor(m1, 32), lo = __shfl_xor(l1, 32);
      Mx = fmaxf(m1, mo);
      const float L = l1 * __builtin_amdgcn_exp2f(m1 - Mx) + lo * __builtin_amdgcn_exp2f(mo - Mx);
      invL = L > 0.f ? 1.f / L : 0.f;
    }
    f32x16 fin[2];
    {
      f32x16 oc[2];
#pragma unroll
      for (int i = 0; i < 16; ++i) { oc[0][i] = 0.f; oc[1][i] = 0.f; }
      uint4 rk2 = att_gload(KCMP + ((size_t)bh * 1024) * 64, tid), rv2 = att_gload(VCMPT + ((size_t)(bh * 16) * 64) * 64, tid);
      for (int kt = 0; kt < ntile; ++kt) {
        __syncthreads();
        att_lstore(sK, rk2, tid); att_lstore(sV, rv2, tid);
        { const int kn = kt + 1 < ntile ? kt + 1 : kt;
          rk2 = att_gload(KCMP + ((size_t)bh * 1024 + 64 * kn) * 64, tid); rv2 = att_gload(VCMPT + ((size_t)(bh * 16 + kn) * 64) * 64, tid); }
        __syncthreads();
#pragma unroll
        for (int kh = 0; kh < 2; ++kh) {
          f32x16 sa;
#pragma unroll
          for (int i = 0; i < 16; ++i) sa[i] = 0.f;
#pragma unroll
          for (int ks = 0; ks < 4; ++ks) sa = mfma32(*reinterpret_cast<const bf16x8*>(sK + (32 * kh + r) * 72 + 16 * ks + 8 * h), Qf[ks], sa);
          float pp[16];
#pragma unroll
          for (int i = 0; i < 16; ++i) { const int key = 64 * kt + 32 * kh + crow16(i, h); pp[i] = (16 * key + 31 <= t) ? __builtin_amdgcn_exp2f(sa[i] - Mx) * invL : 0.f; }
#pragma unroll
          for (int a = 0; a < 4; ++a) {
            float v = 2.f * (pp[4 * a] + pp[4 * a + 1] + pp[4 * a + 2]) + pp[4 * a + 3], wv = pp[4 * a + 3];
            v += __uint_as_float(dpp_mov<0xB1>(__float_as_uint(v))); v += __uint_as_float(dpp_mov<0x4E>(__float_as_uint(v)));
            wv += __uint_as_float(dpp_mov<0xB1>(__float_as_uint(wv))); wv += __uint_as_float(dpp_mov<0x4E>(__float_as_uint(wv)));
            const int blk = 16 * kt + 8 * kh + 2 * a + h;
            if (g == a) { atomicAdd(&imp[(8 * w + ql) * 257 + blk], v); if (blk + 1 < 256) atomicAdd(&imp[(8 * w + ql) * 257 + blk + 1], wv); }
          }
#pragma unroll
          for (int s2 = 0; s2 < 2; ++s2) {
            const bf16x8 pb = pack8(pp[8 * s2], pp[8 * s2 + 1], pp[8 * s2 + 2], pp[8 * s2 + 3], pp[8 * s2 + 4], pp[8 * s2 + 5], pp[8 * s2 + 6], pp[8 * s2 + 7]);
#pragma unroll
            for (int dt = 0; dt < 2; ++dt)
              oc[dt] = mfma32(*reinterpret_cast<const bf16x8*>(sV + (32 * dt + r) * 72 + 32 * kh + 16 * s2 + 8 * h), pb, oc[dt]);
          }
        }
      }
#pragma unroll
      for (int i = 0; i < 16; ++i) { fin[0][i] = gc * oc[0][i]; fin[1][i] = gc * oc[1][i]; }
    }
    if (qt <= 15) {
      if (lane <= qt) msk[lane] = 0xff;
    } else {
      if (lane == 0) { msk[0] = 0xff; msk[qt - 1] = 0xff; msk[qt] = 0xff; }
      const unsigned long long lt_mask = (1ull << lane) - 1ull;
#pragma unroll 1
      for (int rep = 0; rep < ATT_REP_TOPK; ++rep) {
        unsigned sel8[4] = {0u, 0u, 0u, 0u};
#pragma unroll 1
        for (int qi = 0; qi < 8; ++qi) {
          unsigned key[4];
#pragma unroll
          for (int k = 0; k < 4; ++k) {
            const int blk = lane + 64 * k;
            const bool ok = blk >= 1 && blk <= qt - 2;
            key[k] = ok ? __float_as_uint(imp[(8 * w + qi) * 257 + blk]) + 1u : 0u;
          }
          unsigned thr = 0u;
#pragma unroll 1
          for (int bb = 30; bb >= 0; --bb) {
            const unsigned cand = thr | (1u << bb);
            const int cnt = __popcll(__ballot(key[0] >= cand)) + __popcll(__ballot(key[1] >= cand)) +
                            __popcll(__ballot(key[2] >= cand)) + __popcll(__ballot(key[3] >= cand));
            if (cnt >= 13) thr = cand;
          }
          const int cgt = __popcll(__ballot(key[0] > thr)) + __popcll(__ballot(key[1] > thr)) +
                          __popcll(__ballot(key[2] > thr)) + __popcll(__ballot(key[3] > thr));
          const int need = 13 - cgt;
          int before = 0;
#pragma unroll
          for (int k = 0; k < 4; ++k) {
            const bool eq = key[k] == thr;
            const unsigned long long em = __ballot(eq);
            const int rank = before + __popcll(em & lt_mask);
            if (key[k] > thr || (eq && rank < need)) sel8[k] |= 1u << qi;
            before += __popcll(em);
          }
        }
#pragma unroll
        for (int k = 0; k < 4; ++k) if (sel8[k]) msk[lane + 64 * k] |= (unsigned char)sel8[k];
      }
    }
    {
      float mw = -1e30f, lw = 0.f;
      f32x16 ow[2];
#pragma unroll
      for (int i = 0; i < 16; ++i) { ow[0][i] = 0.f; ow[1][i] = 0.f; }
      const int kt_lo = qt - 8 > 0 ? qt - 8 : 0;
#pragma unroll 1
      for (int rep = 0; rep < ATT_REP_WIN; ++rep) { mw = -1e30f; lw = 0.f;
#pragma unroll
      for (int i = 0; i < 16; ++i) { ow[0][i] = 0.f; ow[1][i] = 0.f; }
      uint4 rk3 = att_gload(KW + ((size_t)bh * S_ + (size_t)kt_lo * 64) * 64, tid), rv3 = att_gload(VWT + ((size_t)(bh * 256 + kt_lo) * 64) * 64, tid);
      for (int kt = kt_lo; kt <= qt; ++kt) {
        __syncthreads();
        att_lstore(sK, rk3, tid); att_lstore(sV, rv3, tid);
        { const int kn = kt < qt ? kt + 1 : kt;
          rk3 = att_gload(KW + ((size_t)bh * S_ + (size_t)kn * 64) * 64, tid); rv3 = att_gload(VWT + ((size_t)(bh * 256 + kn) * 64) * 64, tid); }
        __syncthreads();
        f32x16 sa[2];
#pragma unroll
        for (int kh = 0; kh < 2; ++kh) {
#pragma unroll
          for (int i = 0; i < 16; ++i) sa[kh][i] = 0.f;
#pragma unroll
          for (int ks = 0; ks < 4; ++ks) sa[kh] = mfma32(*reinterpret_cast<const bf16x8*>(sK + (32 * kh + r) * 72 + 16 * ks + 8 * h), Qf[ks], sa[kh]);
        }
        float tm = -1e30f;
#pragma unroll
        for (int kh = 0; kh < 2; ++kh)
#pragma unroll
          for (int i = 0; i < 16; ++i) {
            const int key = 64 * kt + 32 * kh + crow16(i, h);
            const bool ok = key <= t && t - key < 512;
            sa[kh][i] = ok ? sa[kh][i] : -INFINITY;
            tm = fmaxf(tm, sa[kh][i]);
          }
        tm = fmax_x32(tm);
        const float mn = fmaxf(mw, tm), al = __builtin_amdgcn_exp2f(mw - mn);
        mw = mn; lw *= al;
#pragma unroll
        for (int i = 0; i < 16; ++i) { ow[0][i] *= al; ow[1][i] *= al; }
        float sum = 0.f;
#pragma unroll
        for (int kh = 0; kh < 2; ++kh)
#pragma unroll
          for (int i = 0; i < 16; ++i) { const float e = __builtin_amdgcn_exp2f(sa[kh][i] - mn); sa[kh][i] = e; sum += e; }
        lw += sum;
#pragma unroll
        for (int kh = 0; kh < 2; ++kh)
#pragma unroll
          for (int s2 = 0; s2 < 2; ++s2) {
            const bf16x8 pb = pack8(sa[kh][8 * s2], sa[kh][8 * s2 + 1], sa[kh][8 * s2 + 2], sa[kh][8 * s2 + 3], sa[kh][8 * s2 + 4], sa[kh][8 * s2 + 5], sa[kh][8 * s2 + 6], sa[kh][8 * s2 + 7]);
#pragma unroll
            for (int dt = 0; dt < 2; ++dt)
              ow[dt] = mfma32(*reinterpret_cast<const bf16x8*>(sV + (32 * dt + r) * 72 + 32 * kh + 16 * s2 + 8 * h), pb, ow[dt]);
          }
      }
      }
      lw = fsum_x32(lw);
      const float scl = gw / lw;
#pragma unroll
      for (int i = 0; i < 16; ++i) { fin[0][i] += scl * ow[0][i]; fin[1][i] += scl * ow[1][i]; }
    }
    __syncthreads();
    int urank = 0; bool uhas = false;
    const int tidc = tid_opaque(), wc_ = tidc >> 6, lanec = tidc & 63;
    if (tidc < 256) {
      unsigned any = 0;
#pragma unroll
      for (int ww = 0; ww < 8; ++ww) any |= reinterpret_cast<unsigned char*>(smem + ATT_MSK)[ww * 256 + tidc];
      uhas = any != 0;
      const unsigned long long bal = __ballot(uhas);
      if (lanec == 0) reinterpret_cast<int*>(smem + ATT_UCNT)[wc_] = __popcll(bal);
      urank = __popcll(bal & ((1ull << lanec) - 1ull));
    }
    __syncthreads();
    const int nU = ucnt[0] + ucnt[1] + ucnt[2] + ucnt[3];
    if (tidc < 256 && uhas) {
      int base = 0;
#pragma unroll
      for (int v = 0; v < 3; ++v) if (v < wc_) base += ucnt[v];
      ulist[base + urank] = (unsigned short)tidc;
    }
    __syncthreads();
    {
      const int tid2 = tid_opaque(), fr = tid2 & 15, fq = (tid2 >> 4) & 3, slot = fr >> 2, gg = fr & 3, w2 = tid2 >> 6;
      const unsigned char* msk2 = reinterpret_cast<const unsigned char*>(smem + ATT_MSK) + w2 * 256;
      const int ld_s = tid2 >> 8, ld_which = (tid2 >> 7) & 1, ld_row = (tid2 & 127) >> 1, ld_half = tid2 & 1;
      const int nchunk = (nU + 3) >> 2;
      uint4 sg0, sg1, sg2, sg3;
#define SLC_GLOAD(c_, hf_) do { int idx_ = 4 * (c_) + 2 * (hf_) + ld_s; idx_ = idx_ < nU ? idx_ : nU - 1; const int blk_ = ulist[idx_]; \
          const uint4* src_ = reinterpret_cast<const uint4*>(ld_which ? VST + ((size_t)(bh * 256 + blk_) * 64 + ld_row) * 64 + ld_half * 32 \
                                                                     : KS + ((size_t)bh * S_ + (size_t)blk_ * 64 + ld_row) * 64 + ld_half * 32); \
          sg0 = src_[0]; sg1 = src_[1]; sg2 = src_[2]; sg3 = src_[3]; } while (0)
#define SLC_LSTORE(c_, hf_) do { char* dst_ = smem + ATT_RING + (((c_) & 1) * 4 + 2 * (hf_) + ld_s) * 16384 + ld_which * 8192 + ld_row * 128; \
          const int sw_ = ld_row & 7, cb_ = ld_half * 4; \
          *reinterpret_cast<uint4*>(dst_ + (((cb_ + 0) ^ sw_) << 4)) = sg0; *reinterpret_cast<uint4*>(dst_ + (((cb_ + 1) ^ sw_) << 4)) = sg1; \
          *reinterpret_cast<uint4*>(dst_ + (((cb_ + 2) ^ sw_) << 4)) = sg2; *reinterpret_cast<uint4*>(dst_ + (((cb_ + 3) ^ sw_) << 4)) = sg3; } while (0)
      bf16x8 qA[2], qB[2];
#pragma unroll
      for (int ks = 0; ks < 2; ++ks) {
        qA[ks] = *reinterpret_cast<const bf16x8*>(Q + ((size_t)b * S_ + q0 + 8 * w2 + slot) * 512 + (hkv * 4 + gg) * 64 + 32 * ks + 8 * fq);
        qB[ks] = *reinterpret_cast<const bf16x8*>(Q + ((size_t)b * S_ + q0 + 8 * w2 + slot + 4) * 512 + (hkv * 4 + gg) * 64 + 32 * ks + 8 * fq);
      }
      f32x4 osA[4], osB[4];
#pragma unroll
      for (int dt = 0; dt < 4; ++dt) { osA[dt] = f32x4{0.f, 0.f, 0.f, 0.f}; osB[dt] = f32x4{0.f, 0.f, 0.f, 0.f}; }
      float mA = -1e30f, lA = 0.f, mB = -1e30f, lB = 0.f;
      auto step = [&](f32x4 (&os)[4], float& mrun, float& lrun, const bf16x8 (&qfr)[2], int qbase, const char* Kl, const char* Vl, int jb, int bits) {
        const bool act = (bits >> slot) & 1;
        const float si = act ? 0.f : -INFINITY;
        f32x4 sc[4];
#pragma unroll
        for (int m = 0; m < 4; ++m) {
          sc[m] = f32x4{si, si, si, si};
#pragma unroll
          for (int ks = 0; ks < 2; ++ks)
            sc[m] = mfma16(*reinterpret_cast<const bf16x8*>(Kl + (16 * m + fr) * 128 + (((4 * ks + fq) ^ (fr & 7)) << 4)), qfr[ks], sc[m]);
        }
        if (jb == qt) {
          const int lim = 8 * w2 + qbase + slot;
#pragma unroll
          for (int m = 0; m < 4; ++m)
#pragma unroll
            for (int j = 0; j < 4; ++j) if (16 * m + 4 * fq + j > lim) sc[m][j] = -INFINITY;
        }
        float bm = -1e30f;
#pragma unroll
        for (int m = 0; m < 4; ++m)
#pragma unroll
          for (int j = 0; j < 4; ++j) bm = fmaxf(bm, sc[m][j]);
        bm = fmax_x32(fmax_x16(bm));
        const float mn = fmaxf(mrun, bm), al = __builtin_amdgcn_exp2f(mrun - mn);
        float sum = 0.f;
#pragma unroll
        for (int m = 0; m < 4; ++m)
#pragma unroll
          for (int j = 0; j < 4; ++j) { const float e = __builtin_amdgcn_exp2f(sc[m][j] - mn); sc[m][j] = e; sum += e; }
        mrun = mn; lrun = lrun * al + sum;
#pragma unroll
        for (int dt = 0; dt < 4; ++dt) os[dt] *= al;
#pragma unroll
        for (int u2 = 0; u2 < 2; ++u2) {
          const bf16x8 pb = pack8(sc[2 * u2][0], sc[2 * u2][1], sc[2 * u2][2], sc[2 * u2][3], sc[2 * u2 + 1][0], sc[2 * u2 + 1][1], sc[2 * u2 + 1][2], sc[2 * u2 + 1][3]);
#pragma unroll
          for (int dt = 0; dt < 4; ++dt)
            os[dt] = mfma16(*reinterpret_cast<const bf16x8*>(Vl + (16 * dt + fr) * 128 + (((4 * u2 + fq) ^ (fr & 7)) << 4)), pb, os[dt]);
        }
      };
      auto proc_blk = [&](int c, int s2) {
        if (4 * c + s2 < nU) {
          const int jb = __builtin_amdgcn_readfirstlane((int)ulist[4 * c + s2]);
          const int mk = __builtin_amdgcn_readfirstlane((int)msk2[jb]);
          const char* Kl = smem + ATT_RING + ((c & 1) * 4 + s2) * 16384;
          if (mk & 15) step(osA, mA, lA, qA, 0, Kl, Kl + 8192, jb, mk & 15);
          if (mk >> 4) step(osB, mB, lB, qB, 4, Kl, Kl + 8192, jb, mk >> 4);
        }
      };
#pragma unroll 1
      for (int rep = 0; rep < ATT_REP_SLC; ++rep) {
        if (rep > 0) {
          __syncthreads();
#pragma unroll
          for (int dt = 0; dt < 4; ++dt) { osA[dt] = f32x4{0.f, 0.f, 0.f, 0.f}; osB[dt] = f32x4{0.f, 0.f, 0.f, 0.f}; }
          mA = -1e30f; lA = 0.f; mB = -1e30f; lB = 0.f;
        }
        SLC_GLOAD(0, 0); SLC_LSTORE(0, 0); SLC_GLOAD(0, 1); SLC_LSTORE(0, 1);
        __syncthreads();
#pragma unroll 1
        for (int c = 0; c < nchunk; ++c) {
          SLC_GLOAD(c + 1, 0);
          proc_blk(c, 0); proc_blk(c, 1);
          SLC_LSTORE(c + 1, 0);
          SLC_GLOAD(c + 1, 1);
          proc_blk(c, 2); proc_blk(c, 3);
          SLC_LSTORE(c + 1, 1);
          __syncthreads();
        }
      }
      {
        float* exch = reinterpret_cast<float*>(smem + ATT_RING) + w2 * 2048;
        const float ltA = fsum_x32(fsum_x16(lA)), ltB = fsum_x32(fsum_x16(lB));
        const size_t tokA = (size_t)b * S_ + q0 + 8 * w2 + slot;
        const float sA = NG[tokA * 24 + (hkv * 4 + gg) * 3 + 1] / ltA, sB = NG[(tokA + 4) * 24 + (hkv * 4 + gg) * 3 + 1] / ltB;
#pragma unroll
        for (int dt = 0; dt < 4; ++dt) {
          *reinterpret_cast<f32x4*>(exch + (slot * 4 + gg) * 64 + 16 * dt + 4 * fq) = osA[dt] * sA;
          *reinterpret_cast<f32x4*>(exch + ((slot + 4) * 4 + gg) * 64 + 16 * dt + 4 * fq) = osB[dt] * sB;
        }
        __builtin_amdgcn_wave_barrier();
        const int row = (tid2 & 31), h2 = (tid2 >> 5) & 1;
#pragma unroll
        for (int dt = 0; dt < 2; ++dt)
#pragma unroll
          for (int a = 0; a < 4; ++a) {
            const f32x4 v = *reinterpret_cast<const f32x4*>(exch + row * 64 + 32 * dt + 8 * a + 4 * h2);
            fin[dt][4 * a] += v[0]; fin[dt][4 * a + 1] += v[1]; fin[dt][4 * a + 2] += v[2]; fin[dt][4 * a + 3] += v[3];
          }
      }
    }
    {
      const int tid3 = tid_opaque(), r3 = tid3 & 31, h3 = (tid3 >> 5) & 1, w3 = tid3 >> 6;
      const size_t tok3 = (size_t)b * S_ + q0 + 8 * w3 + (r3 >> 2);
      const int head3 = hkv * 4 + (r3 & 3);
#pragma unroll
      for (int dt = 0; dt < 2; ++dt)
#pragma unroll
        for (int a = 0; a < 4; ++a)
          *reinterpret_cast<uint2*>(O + blk_off((int)tok3, 512, head3) + 32 * dt + 8 * a + 4 * h3) =
              make_uint2(pk2(fin[dt][4 * a], fin[dt][4 * a + 1]), pk2(fin[dt][4 * a + 2], fin[dt][4 * a + 3]));
    }
  }
}
DI void phg_gates(const P& p, int l, int half, char* smem) {
  char* ws = p.ws;
  const u16* XB = (const u16*)(ws + OFF_XB);
  const u16* Wt = (const u16*)(ws + OFF_W + l * WL_SIZE + WL_WGT);
  uint2* GF = (uint2*)(ws + RB_GF);
  for (int u = blockIdx.x; u < tile_slots(64 * 12); u += gridDim.x) {
    int rtl, cg; if (!tile_map(u, 64, 12, rtl, cg)) continue;
    const int brow = (half * 64 + rtl) * 256;
    int a0, a1, a2, a3; plain_rows(brow, a0, a1, a2, a3);
    f32x4 acc[2][2][4][2];
    gemm256<true, true>(XB, 1024, a0, a1, a2, a3, Wt, 1024, cg * 256, 16, (u16*)smem, acc);
    EPI_COORDS
    uint2* gt = GF + (size_t)(rtl * 12 + cg) * (32 * 512);
    EPI_LOOP {
      const int idx = ((ai * 2 + bj) * 4 + m) * 2 + n;
      const f32x4 v = acc[ai][bj][m][n];
      gt[idx * 512 + e_tz] = make_uint2(pk2(fsigmoid(v[0]), fsigmoid(v[1])), pk2(fsigmoid(v[2]), fsigmoid(v[3])));
    }
  }
}

DI void ph4_merge(const P& p, int l, int half, char* smem) {
  char* ws = p.ws;
  const char* wl = ws + OFF_W + l * WL_SIZE;
  u16* MRG = (u16*)(ws + RB_MRG);
  uint2* GF = (uint2*)(ws + RB_GF);
  for (int u = blockIdx.x; u < tile_slots(64 * 4); u += gridDim.x) {
    int rtl, ct; if (!tile_map(u, 64, 4, rtl, ct)) continue;
    const int brow = (half * 64 + rtl) * 256;
    uint2* run = GF + (size_t)(rtl * 12 + ct) * (32 * 512);
#pragma unroll 1
    for (int br = 0; br < 3; ++br) {
      f32x4 acc[2][2][4][2];
      int a0, a1, a2, a3; plain_rows(brow, a0, a1, a2, a3);
      const u16* Ab = (const u16*)(ws + (br == 0 ? RB_DB : br == 1 ? RB_YB : RB_O));
      const u16* Wb = (const u16*)(wl + (br == 0 ? WL_WEFF : br == 1 ? WL_WSG : WL_WNSA));
      gemm256<true, true>(Ab, 512, a0, a1, a2, a3, Wb, 512, ct * 256, 8, (u16*)smem, acc);
      EPI_COORDS
      const uint2* gt = GF + (size_t)(rtl * 12 + br * 4 + ct) * (32 * 512);
#pragma unroll
      for (int ai = 0; ai < 2; ++ai)
#pragma unroll
        for (int bj = 0; bj < 2; ++bj)
#pragma unroll
          for (int mh = 0; mh < 2; ++mh) {
            uint2 gg[2][2], pm[2][2];
#pragma unroll
            for (int mm = 0; mm < 2; ++mm)
#pragma unroll
              for (int n = 0; n < 2; ++n) {
                const int idx = ((ai * 2 + bj) * 4 + mh * 2 + mm) * 2 + n;
                gg[mm][n] = gt[idx * 512 + e_tz];
                pm[mm][n] = br > 0 ? run[idx * 512 + e_tz] : make_uint2(0u, 0u);
              }
#pragma unroll
            for (int mm = 0; mm < 2; ++mm)
#pragma unroll
              for (int n = 0; n < 2; ++n) {
                const int m = mh * 2 + mm;
                const int idx = ((ai * 2 + bj) * 4 + m) * 2 + n;
                f32x4 v = acc[ai][bj][m][n];
                v[0] = v[0] * bflo(gg[mm][n].x) + bflo(pm[mm][n].x); v[1] = v[1] * bfhi(gg[mm][n].x) + bfhi(pm[mm][n].x);
                v[2] = v[2] * bflo(gg[mm][n].y) + bflo(pm[mm][n].y); v[3] = v[3] * bfhi(gg[mm][n].y) + bfhi(pm[mm][n].y);
                if (br < 2) {
                  run[idx * 512 + e_tz] = make_uint2(pk2(v[0], v[1]), pk2(v[2], v[3]));
                } else {
                  const int col = ct * 256 + bj * 128 + wc * 32 + n * 16 + fr;
#pragma unroll
                  for (int j = 0; j < 4; ++j) MRG[(size_t)(brow + ai * 128 + wr * 64 + m * 16 + fq * 4 + j) * 1024 + col] = f2bf(v[j]);
                }
              }
          }
    }
  }
}

DI void ph5_out(const P& p, int l, char* smem) {
  char* ws = p.ws;
  const u16* MRG = (const u16*)(ws + RB_MRG);
  const u16* Wt = (const u16*)(ws + OFF_W + l * WL_SIZE + WL_WOUT);
  const float* xin = l == 0 ? p.x : p.out;
  for (int u = blockIdx.x; u < tile_slots(512); u += gridDim.x) {
    int rt, ct; if (!tile_map(u, 128, 4, rt, ct)) continue;
    const int brow = rt * 256;
    int a0, a1, a2, a3; plain_rows(brow, a0, a1, a2, a3);
    f32x4 acc[2][2][4][2];
    gemm256<false, true>(MRG, 1024, a0, a1, a2, a3, Wt, 1024, ct * 256, 16, (u16*)smem, acc);
    EPI_COORDS
#pragma unroll
    for (int ai = 0; ai < 2; ++ai)
#pragma unroll
      for (int bj = 0; bj < 2; ++bj) {
        const size_t base = (size_t)(brow + ai * 128 + wr * 64 + fq * 4) * 1024 + ct * 256 + bj * 128 + wc * 32 + fr;
        float old[4][2][4];
#pragma unroll
        for (int m = 0; m < 4; ++m)
#pragma unroll
          for (int n = 0; n < 2; ++n)
#pragma unroll
            for (int j = 0; j < 4; ++j) old[m][n][j] = xin[base + (size_t)(m * 16 + j) * 1024 + n * 16];
#pragma unroll
        for (int m = 0; m < 4; ++m)
#pragma unroll
          for (int n = 0; n < 2; ++n)
#pragma unroll
            for (int j = 0; j < 4; ++j) p.out[base + (size_t)(m * 16 + j) * 1024 + n * 16] = ALPHA_ * old[m][n][j] + acc[ai][bj][m][n][j];
      }
  }
}

template <int WHICH, bool MOE>
DI void ph_ln(const P& p, int l, char* smem) {
  char* ws = p.ws;
  const int tid = tid_opaque(), w = tid >> 6, lane = tid & 63;
  const float* gam = (WHICH == 1 ? p.ln1_g : p.ln2_g) + (size_t)l * 1024;
  const float* bet = (WHICH == 1 ? p.ln1_b : p.ln2_b) + (size_t)l * 1024;
  u16* XB = (u16*)(ws + OFF_XB);
  int* lcnt = reinterpret_cast<int*>(smem);
  float* srw = reinterpret_cast<float*>(smem + 1024);
  if (MOE) { for (int i = tid; i < 8192 / 4; i += NTHR) reinterpret_cast<float4*>(srw)[i] = reinterpret_cast<const float4*>(p.moe_r)[i]; __syncthreads(); }
  int* TOKE = (int*)(ws + OFF_TOKE); float* TOKW = (float*)(ws + OFF_TOKW);
  unsigned* gcnt = (unsigned*)(ws + OFF_CNT);
  float4 gv[4], bv[4];
#pragma unroll
  for (int i = 0; i < 4; ++i) { gv[i] = *reinterpret_cast<const float4*>(gam + (i * 64 + lane) * 4); bv[i] = *reinterpret_cast<const float4*>(bet + (i * 64 + lane) * 4); }
  for (int rb = blockIdx.x; rb < 256; rb += gridDim.x) {
    if (MOE) { __syncthreads(); if (tid < 24) lcnt[tid] = 0; __syncthreads(); }
    float4 vn[4], vm[4];
    float4 pn = make_float4(0.f, 0.f, 0.f, 0.f), pm = pn;
#pragma unroll
    for (int i = 0; i < 4; ++i) {
      vn[i] = *reinterpret_cast<const float4*>(p.out + (size_t)(rb * 128 + w * 16) * 1024 + (i * 64 + lane) * 4);
      vm[i] = *reinterpret_cast<const float4*>(p.out + (size_t)(rb * 128 + w * 16 + 1) * 1024 + (i * 64 + lane) * 4);
    }
    if (WHICH == 1) {
      pn = *reinterpret_cast<const float4*>(p.p + ((size_t)l * T_ + rb * 128 + w * 16) * 256 + lane * 4);
      pm = *reinterpret_cast<const float4*>(p.p + ((size_t)l * T_ + rb * 128 + w * 16 + 1) * 256 + lane * 4);
    }
#pragma unroll 1
    for (int ri = 0; ri < 16; ++ri) {
      const int row = rb * 128 + w * 16 + ri;
      float* xr = p.out + (size_t)row * 1024;
      float4 v[4];
#pragma unroll
      for (int i = 0; i < 4; ++i) { v[i] = vn[i]; vn[i] = vm[i]; }
      const float4 pv = pn; pn = pm;
      {
        const int rn = ri < 14 ? row + 2 : row;
#pragma unroll
        for (int i = 0; i < 4; ++i) vm[i] = *reinterpret_cast<const float4*>(p.out + (size_t)rn * 1024 + (i * 64 + lane) * 4);
        if (WHICH == 1) pm = *reinterpret_cast<const float4*>(p.p + ((size_t)l * T_ + rn) * 256 + lane * 4);
      }
      float s = 0.f;
#pragma unroll
      for (int i = 0; i < 4; ++i) s += v[i].x + v[i].y + v[i].z + v[i].w;
      const float mu = wave_sum(s) * (1.f / 1024.f);
      float q = 0.f;
#pragma unroll
      for (int i = 0; i < 4; ++i) { v[i].x -= mu; v[i].y -= mu; v[i].z -= mu; v[i].w -= mu; q += v[i].x * v[i].x + v[i].y * v[i].y + v[i].z * v[i].z + v[i].w * v[i].w; }
      const float rs = rsqrtf(wave_sum(q) * (1.f / 1024.f) + 1e-5f);
#pragma unroll
      for (int i = 0; i < 4; ++i) {
        v[i].x = v[i].x * rs * gv[i].x + bv[i].x; v[i].y = v[i].y * rs * gv[i].y + bv[i].y;
        v[i].z = v[i].z * rs * gv[i].z + bv[i].z; v[i].w = v[i].w * rs * gv[i].w + bv[i].w;
        const float sc = WHICH == 1 ? ALPHA_ : 1.f;
        *reinterpret_cast<float4*>(xr + (i * 64 + lane) * 4) = make_float4(sc * v[i].x, sc * v[i].y, sc * v[i].z, sc * v[i].w);
        *reinterpret_cast<uint2*>(XB + blk_off(row, 1024, (i * 64 + lane) >> 4) + (((i * 64 + lane) * 4) & 63)) = make_uint2(pk2(v[i].x, v[i].y), pk2(v[i].z, v[i].w));
      }
      if (WHICH == 1) {
        *reinterpret_cast<uint2*>((u16*)(ws + RB_PB) + (size_t)row * 256 + lane * 4) = make_uint2(pk2(pv.x, pv.y), pk2(pv.z, pv.w));
      }
      if (MOE) {
        const float* wr_ = srw;
        float lg[8];
#pragma unroll
        for (int e = 0; e < 8; ++e) lg[e] = 0.f;
#pragma unroll
        for (int i = 0; i < 4; ++i) {
          const float xs[4] = {v[i].x, v[i].y, v[i].z, v[i].w};
#pragma unroll
          for (int k = 0; k < 4; ++k) {
            const float4 wa = *reinterpret_cast<const float4*>(wr_ + (size_t)((i * 64 + lane) * 4 + k) * 8);
            const float4 wb = *reinterpret_cast<const float4*>(wr_ + (size_t)((i * 64 + lane) * 4 + k) * 8 + 4);
            lg[0] += xs[k] * wa.x; lg[1] += xs[k] * wa.y; lg[2] += xs[k] * wa.z; lg[3] += xs[k] * wa.w;
            lg[4] += xs[k] * wb.x; lg[5] += xs[k] * wb.y; lg[6] += xs[k] * wb.z; lg[7] += xs[k] * wb.w;
          }
        }
#pragma unroll
        for (int e = 0; e < 8; ++e) lg[e] = wave_sum(lg[e]) + p.moe_rb[e];
        if (lane == 0) {
          int e0 = 0; float b0 = lg[0];
#pragma unroll
          for (int e = 1; e < 8; ++e) if (lg[e] > b0) { b0 = lg[e]; e0 = e; }
          int e1 = -1; float b1 = -3.0e38f;
#pragma unroll
          for (int e = 0; e < 8; ++e) if (e != e0 && lg[e] > b1) { b1 = lg[e]; e1 = e; }
          const float ex = __expf(b1 - b0), w0 = 1.f / (1.f + ex), w1 = ex * w0;
          TOKE[row * 2] = e0; TOKE[row * 2 + 1] = e1; TOKW[row * 2] = w0; TOKW[row * 2 + 1] = w1;
          atomicAdd(&lcnt[e0], 1); atomicAdd(&lcnt[e1], 1);
        }
      }
    }
    if (MOE) {
      int* ROWT = (int*)(ws + OFF_ROWT); float* ROWW = (float*)(ws + OFF_ROWW);
      __syncthreads();
      if (tid < 8) lcnt[8 + tid] = (int)atomicAdd(&gcnt[tid * 64], (unsigned)lcnt[tid]);
      __syncthreads();
      if (tid < 256) {
        const int tk = rb * 128 + (tid >> 1), sl = tid & 1;
        const int e = TOKE[tk * 2 + sl];
        const int pos = lcnt[8 + e] + atomicAdd(&lcnt[16 + e], 1);
        ROWT[e * 65536 + pos] = tk; ROWW[e * 65536 + pos] = TOKW[tk * 2 + sl];
      }
    }
  }
}

DI void ph_ple(const P& p, int l, char* smem) {
  char* ws = p.ws;
  const u16* XB = (const u16*)(ws + OFF_XB);
  const u16* PB = (const u16*)(ws + RB_PB);
  const char* wl = ws + OFF_W + l * WL_SIZE;
  const float* gb = p.ple_gb + (size_t)l * 1024;
  unsigned* scr = (unsigned*)(ws + RB_SCRP) + (size_t)blockIdx.x * (32 * 512 * 2);
  for (int u = blockIdx.x; u < tile_slots(512); u += gridDim.x) {
    int rt, ct; if (!tile_map(u, 128, 4, rt, ct)) continue;
    const int brow = rt * 256;
    int a0, a1, a2, a3; plain_rows(brow, a0, a1, a2, a3);
    f32x4 acc[2][2][4][2];
    gemm256<false, true>(PB, 256, a0, a1, a2, a3, (const u16*)(wl + WL_WPP), 256, ct * 256, 4, (u16*)smem, acc);
    {
      EPI_COORDS
      EPI_LOOP {
        const int idx = ((ai * 2 + bj) * 4 + m) * 2 + n;
        const f32x4 v = acc[ai][bj][m][n];
        *reinterpret_cast<uint2*>(scr + ((size_t)idx * 512 + e_tz) * 2) = make_uint2(pk2(v[0], v[1]), pk2(v[2], v[3]));
      }
    }
    plain_rows(brow, a0, a1, a2, a3);
    gemm256<true, true>(XB, 1024, a0, a1, a2, a3, (const u16*)(wl + WL_WPG), 1024, ct * 256, 16, (u16*)smem, acc);
    {
      EPI_COORDS
#pragma unroll
      for (int ai = 0; ai < 2; ++ai)
#pragma unroll
        for (int bj = 0; bj < 2; ++bj) {
          const size_t base = (size_t)(brow + ai * 128 + wr * 64 + fq * 4) * 1024 + ct * 256 + bj * 128 + wc * 32 + fr;
          float old[4][2][4];
#pragma unroll
          for (int m = 0; m < 4; ++m)
#pragma unroll
            for (int n = 0; n < 2; ++n)
#pragma unroll
              for (int j = 0; j < 4; ++j) old[m][n][j] = p.out[base + (size_t)(m * 16 + j) * 1024 + n * 16];
          uint2 ggq[4][2]; float bbq[2];
#pragma unroll
          for (int m = 0; m < 4; ++m)
#pragma unroll
            for (int n = 0; n < 2; ++n) ggq[m][n] = *reinterpret_cast<const uint2*>(scr + ((size_t)(((ai * 2 + bj) * 4 + m) * 2 + n) * 512 + e_tz) * 2);
#pragma unroll
          for (int n = 0; n < 2; ++n) bbq[n] = gb[ct * 256 + bj * 128 + wc * 32 + n * 16 + fr];
#pragma unroll
          for (int m = 0; m < 4; ++m)
#pragma unroll
            for (int n = 0; n < 2; ++n) {
              const uint2 gg = ggq[m][n];
              const float pp[4] = {bflo(gg.x), bfhi(gg.x), bflo(gg.y), bfhi(gg.y)};
              const float bb = bbq[n];
#pragma unroll
              for (int j = 0; j < 4; ++j)
                p.out[base + (size_t)(m * 16 + j) * 1024 + n * 16] = old[m][n][j] + fsigmoid(acc[ai][bj][m][n][j] + bb) * pp[j];
            }
        }
    }
  }
}

DI void ph_ffn_gu(const P& p, char* smem, int half) {
  char* ws = p.ws;
  const u16* XB = (const u16*)(ws + OFF_XB);
  const u16* Wt = (const u16*)(ws + OFF_WFFN);
  u16* ACT = (u16*)(ws + RB_ACT);
  for (int u = blockIdx.x; u < tile_slots(64 * 22); u += gridDim.x) {
    int rt, ct; if (!tile_map(u, 64, 22, rt, ct)) continue;
    rt += half * 64;
    const int brow = rt * 256;
    int a0, a1, a2, a3; plain_rows(brow, a0, a1, a2, a3);
    f32x4 acc[2][2][4][2];
    gemm256<true, true>(XB, 1024, a0, a1, a2, a3, Wt, 1024, ct * 256, 16, (u16*)smem, acc);
    EPI_COORDS
#pragma unroll
    for (int ai = 0; ai < 2; ++ai)
#pragma unroll
      for (int m = 0; m < 4; ++m)
#pragma unroll
        for (int n = 0; n < 2; ++n)
#pragma unroll
          for (int j = 0; j < 4; ++j) {
            const int row = brow + ai * 128 + wr * 64 + m * 16 + fq * 4 + j;
            ACT[(size_t)row * DFF + ct * 128 + wc * 32 + n * 16 + fr] = f2bf(fsilu(acc[ai][0][m][n][j]) * acc[ai][1][m][n][j]);
          }
  }
}
DI void ph_ffn_dn(const P& p, char* smem, int half) {
  char* ws = p.ws;
  const u16* ACT = (const u16*)(ws + RB_ACT);
  const u16* Wt = (const u16*)(ws + OFF_WFFN + (size_t)5632 * 1024 * 2);
  for (int u = blockIdx.x; u < tile_slots(256); u += gridDim.x) {
    int rt, ct; if (!tile_map(u, 64, 4, rt, ct)) continue;
    rt += half * 64;
    const int brow = rt * 256;
    int a0, a1, a2, a3; plain_rows(brow, a0, a1, a2, a3);
    f32x4 acc[2][2][4][2];
    gemm256<false, true>(ACT, DFF, a0, a1, a2, a3, Wt, DFF, ct * 256, 44, (u16*)smem, acc);
    EPI_COORDS
#pragma unroll
    for (int ai = 0; ai < 2; ++ai)
#pragma unroll
      for (int bj = 0; bj < 2; ++bj) {
        const size_t base = (size_t)(brow + ai * 128 + wr * 64 + fq * 4) * 1024 + ct * 256 + bj * 128 + wc * 32 + fr;
        float old[4][2][4];
#pragma unroll
        for (int m = 0; m < 4; ++m)
#pragma unroll
          for (int n = 0; n < 2; ++n)
#pragma unroll
            for (int j = 0; j < 4; ++j) old[m][n][j] = p.out[base + (size_t)(m * 16 + j) * 1024 + n * 16];
#pragma unroll
        for (int m = 0; m < 4; ++m)
#pragma unroll
          for (int n = 0; n < 2; ++n)
#pragma unroll
            for (int j = 0; j < 4; ++j) p.out[base + (size_t)(m * 16 + j) * 1024 + n * 16] = old[m][n][j] + acc[ai][bj][m][n][j];
      }
  }
}

struct MoeMap { int cnt[8]; int tstart[9]; };
DI void moe_map(const P& p, MoeMap& mm) {
  const unsigned* gcnt = (const unsigned*)(p.ws + OFF_CNT);
  int acc = 0;
#pragma unroll
  for (int e = 0; e < 8; ++e) { const int c = __builtin_amdgcn_readfirstlane((int)gcnt[e * 64]); mm.cnt[e] = c; mm.tstart[e] = acc; acc += ((c + 511) >> 9) * 2; }
  mm.tstart[8] = acc;
}
DI void moe_find(const MoeMap& mm, int gt, int& e, int& lt) {
  e = 0;
#pragma unroll
  for (int k = 1; k < 8; ++k) if (gt >= mm.tstart[k]) e = k;
  lt = 0;
#pragma unroll
  for (int k = 0; k < 8; ++k) if (k == e) lt = gt - mm.tstart[k];
}
DI int moe_cnt(const MoeMap& mm, int e) { int c = 0;
#pragma unroll
  for (int k = 0; k < 8; ++k) if (k == e) c = mm.cnt[k];
  return c; }

DI void ph_moe_gu(const P& p, int ch, char* smem) {
  char* ws = p.ws;
  MoeMap mm; moe_map(p, mm);
  const int t0 = ch * 128, t1 = min(mm.tstart[8], t0 + 128);
  const u16* XB = (const u16*)(ws + OFF_XB);
  const int* ROWT = (const int*)(ws + OFF_ROWT);
  u16* ACT = (u16*)(ws + RB_ACT);
  for (int u = blockIdx.x; u < tile_slots((t1 - t0) * 22); u += gridDim.x) {
    int rtl, ct; if (!tile_map(u, t1 - t0, 22, rtl, ct)) continue;
    const int gt = t0 + rtl;
    int e, lt; moe_find(mm, gt, e, lt);
    const int cnt = moe_cnt(mm, e);
    const u16* Wt = (const u16*)(ws + OFF_WMOE + (size_t)e * FFN_E_SIZE);
    int r0, c0; stage_rc(tid_opaque() * 16, r0, c0);
    int ar[4];
#pragma unroll
    for (int k = 0; k < 4; ++k) { const int lr = lt * 256 + r0 + 64 * k; ar[k] = lr < cnt ? ROWT[e * 65536 + lr] : 0; }
    f32x4 acc[2][2][4][2];
    gemm256<true, true, true>(XB, 1024, ar[0], ar[1], ar[2], ar[3], Wt, 1024, ct * 256, 16, (u16*)smem, acc);
    EPI_COORDS
    const int brow = (gt - t0) * 256;
#pragma unroll
    for (int ai = 0; ai < 2; ++ai)
#pragma unroll
      for (int m = 0; m < 4; ++m)
#pragma unroll
        for (int n = 0; n < 2; ++n)
#pragma unroll
          for (int j = 0; j < 4; ++j) {
            const int row = brow + ai * 128 + wr * 64 + m * 16 + fq * 4 + j;
            ACT[(size_t)row * DFF + ct * 128 + wc * 32 + n * 16 + fr] = f2bf(fsilu(acc[ai][0][m][n][j]) * acc[ai][1][m][n][j]);
          }
  }
}
DI void ph_moe_dn(const P& p, int ch, char* smem) {
  char* ws = p.ws;
  MoeMap mm; moe_map(p, mm);
  const int t0 = ch * 128, t1 = min(mm.tstart[8], t0 + 128);
  const u16* ACT = (const u16*)(ws + RB_ACT);
  const int* ROWT = (const int*)(ws + OFF_ROWT);
  const float* ROWW = (const float*)(ws + OFF_ROWW);
  const int ksp = ch == 2 ? 4 : 1;
  for (int u = blockIdx.x; u < tile_slots((t1 - t0) * 4 * ksp); u += gridDim.x) {
    int rtl, cc; if (!tile_map(u, t1 - t0, 4 * ksp, rtl, cc)) continue;
    const int ks = cc % ksp, ct = cc / ksp;
    const int gt = t0 + rtl;
    int e, lt; moe_find(mm, gt, e, lt);
    const int cnt = moe_cnt(mm, e);
    const u16* Wt = (const u16*)(ws + OFF_WMOE + (size_t)e * FFN_E_SIZE + (size_t)5632 * 1024 * 2);
    const int brow = (gt - t0) * 256;
    int a0, a1, a2, a3; plain_rows(brow, a0, a1, a2, a3);
    f32x4 acc[2][2][4][2];
    const int kt0 = ksp == 1 ? 0 : (ks == 0 ? 0 : ks == 1 ? 12 : ks == 2 ? 24 : 34);
    const int ktn = ksp == 1 ? 44 : (ks < 2 ? 12 : 10);
    gemm256<false, true>(ACT, DFF, a0, a1, a2, a3, Wt, DFF, ct * 256, ktn, (u16*)smem, acc, kt0);
    EPI_COORDS
#pragma unroll
    for (int ai = 0; ai < 2; ++ai) {
      int tkq[4][4]; float wtq[4][4];
#pragma unroll
      for (int m = 0; m < 4; ++m)
#pragma unroll
        for (int j = 0; j < 4; ++j) {
          const int lr = lt * 256 + ai * 128 + wr * 64 + m * 16 + fq * 4 + j;
          const bool ok = lr < cnt;
          tkq[m][j] = ok ? ROWT[e * 65536 + lr] : -1;
          wtq[m][j] = ok ? ROWW[e * 65536 + lr] : 0.f;
        }
#pragma unroll
      for (int m = 0; m < 4; ++m)
#pragma unroll
        for (int j = 0; j < 4; ++j) {
          const int tk = tkq[m][j];
          if (tk >= 0) {
            const float wt = wtq[m][j];
#pragma unroll
            for (int bj = 0; bj < 2; ++bj)
#pragma unroll
              for (int n = 0; n < 2; ++n)
                unsafeAtomicAdd(&p.out[(size_t)tk * 1024 + ct * 256 + bj * 128 + wc * 32 + n * 16 + fr], wt * acc[ai][bj][m][n][j]);
          }
        }
    }
  }
}
constexpr int NPH = 35;
template <int ID> DI void run_phase(const P& p, char* smem) {
  if constexpr (ID == 0) prologue_phase(p, smem);
  else if constexpr (ID == 1)  ph1_proj(p, 0, smem);
  else if constexpr (ID == 2)  ph2_mix(p, 0, smem);
  else if constexpr (ID == 3)  ph2b_cmp2(p, 0, smem);
  else if constexpr (ID == 4)  ph3_attn(p, 0, smem);
  else if constexpr (ID == 5)  phg_gates(p, 0, 0, smem);
  else if constexpr (ID == 6)  ph4_merge(p, 0, 0, smem);
  else if constexpr (ID == 7)  phg_gates(p, 0, 1, smem);
  else if constexpr (ID == 8)  ph4_merge(p, 0, 1, smem);
  else if constexpr (ID == 9)  ph5_out(p, 0, smem);
  else if constexpr (ID == 10) ph_ln<1, false>(p, 0, smem);
  else if constexpr (ID == 11) ph_ple(p, 0, smem);
  else if constexpr (ID == 12) ph_ffn_gu(p, smem, 0);
  else if constexpr (ID == 13) ph_ffn_dn(p, smem, 0);
  else if constexpr (ID == 14) ph_ffn_gu(p, smem, 1);
  else if constexpr (ID == 15) ph_ffn_dn(p, smem, 1);
  else if constexpr (ID == 16) ph_ln<2, false>(p, 0, smem);
  else if constexpr (ID == 17) ph1_proj(p, 1, smem);
  else if constexpr (ID == 18) ph2_mix(p, 1, smem);
  else if constexpr (ID == 19) ph2b_cmp2(p, 1, smem);
  else if constexpr (ID == 20) ph3_attn(p, 1, smem);
  else if constexpr (ID == 21) phg_gates(p, 1, 0, smem);
  else if constexpr (ID == 22) ph4_merge(p, 1, 0, smem);
  else if constexpr (ID == 23) phg_gates(p, 1, 1, smem);
  else if constexpr (ID == 24) ph4_merge(p, 1, 1, smem);
  else if constexpr (ID == 25) ph5_out(p, 1, smem);
  else if constexpr (ID == 26) ph_ln<1, true>(p, 1, smem);
  else if constexpr (ID == 27) ph_ple(p, 1, smem);
  else if constexpr (ID == 28) ph_moe_gu(p, 0, smem);
  else if constexpr (ID == 29) ph_moe_dn(p, 0, smem);
  else if constexpr (ID == 30) ph_moe_gu(p, 1, smem);
  else if constexpr (ID == 31) ph_moe_dn(p, 1, smem);
  else if constexpr (ID == 32) ph_moe_gu(p, 2, smem);
  else if constexpr (ID == 33) ph_moe_dn(p, 2, smem);
  else if constexpr (ID == 34) ph_ln<2, false>(p, 1, smem);
}

#ifndef MK_MULTI
#define MK_MULTI 0
#endif

#if MK_MULTI
template <int ID> __global__ void __launch_bounds__(NTHR, 2) k_one(P p) {
  extern __shared__ __attribute__((aligned(16))) char smem[];
  run_phase<ID>(p, smem);
}
typedef void (*kfn_t)(P);
template <int... I> static void launch_all(std::integer_sequence<int, I...>, const P& prm, hipStream_t stream, bool init) {
  kfn_t fns[] = { k_one<I>... };
  for (int i = 0; i < (int)sizeof...(I); ++i) {
    if (init) hipFuncSetAttribute((const void*)fns[i], hipFuncAttributeMaxDynamicSharedMemorySize, LDS_BYTES);
    else hipLaunchKernelGGL(fns[i], dim3(256), dim3(NTHR), LDS_BYTES, stream, prm);
  }
}
#else
constexpr unsigned long long DUPMASK = 0ull;
template <int ID> DI void run_from(const P& p, char* smem, const XcdBarrier& bar) {
  run_phase<ID>(p, smem);
  if constexpr ((DUPMASK >> ID) & 1ull) { xcd_barrier(bar); run_phase<ID>(p, smem); }
  if constexpr (ID + 1 < NPH) { xcd_barrier(bar); run_from<ID + 1>(p, smem, bar); }
}
__global__ void __launch_bounds__(NTHR, 2) k_mega(P p) {
  extern __shared__ __attribute__((aligned(16))) char smem[];
  uint4* xbw = reinterpret_cast<uint4*>(smem + 147456);
  if (threadIdx.x == 0) *xbw = make_uint4(0u, 0u, 0u, 0u);
  __syncthreads();
  XcdBarrier bar = xcd_barrier_post((unsigned*)(p.ws + OFF_BAR), (volatile LAS unsigned*)xbw);
  run_from<0>(p, smem, bar);
}
#endif

extern "C" void kernel_launch(void* const* d_in, const int* in_sizes, int n_in, void* d_out, int out_size, void* d_ws, size_t ws_size, hipStream_t stream) {
  (void)in_sizes; (void)n_in; (void)out_size;
  static_assert(sizeof(P) == 37 * sizeof(void*), "P must be 37 pointers");
  P prm{};
  const void* arr[37];
  for (int i = 0; i < 35; ++i) arr[i] = d_in[i];
  arr[35] = d_out; arr[36] = d_ws;
  memcpy(&prm, arr, sizeof(prm));
  if (ws_size < WS_NEED) { fprintf(stderr, "workspace too small: %zu < %zu\n", ws_size, (size_t)WS_NEED); }
  hipMemsetAsync(d_ws, 0, ZERO_BYTES, stream);
#if MK_MULTI
  static bool inited = false;
  if (!inited) { launch_all(std::make_integer_sequence<int, NPH>{}, prm, stream, true); inited = true; }
  launch_all(std::make_integer_sequence<int, NPH>{}, prm, stream, false);
#else
  static int grid = 0;
  if (!grid) {
    hipFuncSetAttribute((const void*)k_mega, hipFuncAttributeMaxDynamicSharedMemorySize, LDS_BYTES);
    int dev = 0, cus = 0, per_cu = 0;
    hipGetDevice(&dev);
    hipDeviceGetAttribute(&cus, hipDeviceAttributeMultiprocessorCount, dev);
    hipOccupancyMaxActiveBlocksPerMultiprocessor(&per_cu, k_mega, NTHR, LDS_BYTES);
    grid = cus * (per_cu < 1 ? per_cu : 1);
    if (grid <= 0 || grid > 256) grid = 256;
  }
  hipLaunchKernelGGL(k_mega, dim3(grid), dim3(NTHR), LDS_BYTES, stream, prm);
#endif
}
```
